# Optimizing an MI355X kernel written in HIP

```python
import jax, jax.numpy as jnp
from jax import lax
import numpy as np

D_MODEL = 2048
BATCH = 4
SEQ = 2048
DEPTH = 1

NSA_WIDTH = D_MODEL // 2
GLA_WIDTH = D_MODEL - NSA_WIDTH
MIX_WIDTH = NSA_WIDTH + GLA_WIDTH
NSA_HEAD_DIM = 64
NSA_HEADS = NSA_WIDTH // NSA_HEAD_DIM
NSA_KV_HEADS = 4
NSA_Q_PER_KV = NSA_HEADS // NSA_KV_HEADS
CMP_BLOCK = 32
CMP_STRIDE = 16
SEL_BLOCK = 64
N_SEL = 16
WINDOW = 512
N_BRANCH = 3
GLA_HEADS = 4
GLA_DV = GLA_WIDTH // GLA_HEADS
GLA_DK = GLA_DV // 2
GLA_GATE_RANK = 16
GLA_GATE_NORM = 16.0
GLA_CHUNK = 64
N_GROUPS = 4
EXPERTS_PER_GROUP = 8
N_EXPERTS = N_GROUPS * EXPERTS_PER_GROUP
TOP_K = 2
EXPERT_FF = D_MODEL // 4
MOE_BLOCK = 128
EPS = 1e-6
NEG = -1e30
FORCE = 1e30
IN_SPLITS = (NSA_HEADS * NSA_HEAD_DIM,
             2 * N_BRANCH * NSA_KV_HEADS * NSA_HEAD_DIM,
             N_BRANCH * NSA_HEADS,
             GLA_HEADS * GLA_DK,
             GLA_HEADS * GLA_DK,
             GLA_HEADS * GLA_DV,
             GLA_HEADS * GLA_DV,
             GLA_GATE_RANK)
IN_WIDTH = sum(IN_SPLITS)

kernel_name = 'hybrid_nsa_gla_hmoe_block'


def _rmsnorm(x, w):
    xf = x.astype(jnp.float32)
    xf = xf * lax.rsqrt(jnp.mean(xf * xf, axis=-1, keepdims=True) + EPS)
    return (xf * w.astype(jnp.float32)).astype(x.dtype)


def _alibi_slopes(n):
    return jnp.asarray(2.0 ** (-8.0 * np.arange(1, n + 1) / n), dtype=jnp.float32)


def _nsa(q, kv, gate_logits, pos_k, w1_k, w2_k, pos_v, w1_v, w2_v):
    B, S, _ = q.shape
    G, R, Dh = NSA_KV_HEADS, NSA_Q_PER_KV, NSA_HEAD_DIM
    f32 = jnp.float32
    out_dtype = q.dtype
    q = q.reshape(B, S, G, R, Dh).transpose(0, 2, 3, 1, 4) * (Dh ** -0.5)
    k_c, v_c, k_s, v_s, k_w, v_w = [a.reshape(B, S, G, Dh).transpose(0, 2, 1, 3)
                                    for a in jnp.split(kv, 6, axis=-1)]
    slopes = _alibi_slopes(NSA_HEADS).reshape(G, R)
    t = jnp.arange(S)

    n_cmp = (S - CMP_BLOCK) // CMP_STRIDE + 1
    starts = np.arange(n_cmp) * CMP_STRIDE
    tok = starts[:, None] + np.arange(CMP_BLOCK)[None, :]

    def compress(a, pos, w1, w2):
        blk = (a[:, :, tok, :] + pos).reshape(B, G, n_cmp, CMP_BLOCK * Dh)
        return jax.nn.gelu(blk @ w1) @ w2

    kc = compress(k_c, pos_k, w1_k, w2_k)
    vc = compress(v_c, pos_v, w1_v, w2_v)
    blk_end = jnp.asarray(starts + CMP_BLOCK - 1)
    blk_center = jnp.asarray(starts + (CMP_BLOCK - 1) / 2.0, dtype=f32)
    valid_c = blk_end[None, :] <= t[:, None]
    dist_c = t[:, None].astype(f32) - blk_center[None, :]
    s_c = jnp.einsum('bgrsd,bgnd->bgrsn', q, kc).astype(f32)
    s_c = jnp.where(valid_c, s_c - slopes[None, :, :, None, None] * dist_c, NEG)
    p_c = jnp.where(valid_c, jax.nn.softmax(s_c, axis=-1), 0.0)
    o_c = jnp.einsum('bgrsn,bgnd->bgrsd', p_c.astype(vc.dtype), vc)

    nb = S // SEL_BLOCK
    sel_start = np.arange(nb) * SEL_BLOCK
    overlap = ((starts[:, None] < sel_start[None, :] + SEL_BLOCK) &
               (starts[:, None] + CMP_BLOCK > sel_start[None, :])).astype(np.float32)
    imp = jnp.einsum('bgrsn,nj->bgsj', p_c, jnp.asarray(overlap))
    qblk = t // SEL_BLOCK
    j = jnp.arange(nb)
    forced = (j[None, :] == 0) | (j[None, :] == qblk[:, None]) | (j[None, :] == qblk[:, None] - 1)
    imp = jnp.where(forced, FORCE, jnp.where(j[None, :] <= qblk[:, None], imp, NEG))
    n_sel = min(N_SEL, nb)
    _, sel_idx = lax.top_k(imp, n_sel)

    QB = SEL_BLOCK
    nqb = S // QB
    ks_blk = k_s.reshape(B, G, nb, SEL_BLOCK, Dh)
    vs_blk = v_s.reshape(B, G, nb, SEL_BLOCK, Dh)
    kw_pad = jnp.pad(k_w, ((0, 0), (0, 0), (WINDOW, 0), (0, 0)))
    vw_pad = jnp.pad(v_w, ((0, 0), (0, 0), (WINDOW, 0), (0, 0)))
    q_blocks = jnp.moveaxis(q.reshape(B, G, R, nqb, QB, Dh), 3, 0)
    idx_blocks = jnp.moveaxis(sel_idx.reshape(B, G, nqb, QB, n_sel), 2, 0)
    gather = jax.vmap(jax.vmap(lambda blocks, ix: blocks[ix]))

    def block_step(args):
        i, qi, ix = args
        tq = i * QB + jnp.arange(QB)
        kg = gather(ks_blk, ix)
        vg = gather(vs_blk, ix)
        kpos = ix[..., None] * SEL_BLOCK + jnp.arange(SEL_BLOCK)
        dist = tq[None, None, :, None, None] - kpos
        s = jnp.einsum('bgrqd,bgqkld->bgrqkl', qi, kg).astype(f32)
        s = s - slopes[None, :, :, None, None, None] * dist[:, :, None].astype(f32)
        s = jnp.where((dist >= 0)[:, :, None], s, NEG)
        p = jax.nn.softmax(s, axis=(-2, -1))
        o_s = jnp.einsum('bgrqkl,bgqkld->bgrqd', p.astype(vg.dtype), vg)
        kw = lax.dynamic_slice_in_dim(kw_pad, i * QB, WINDOW + QB, axis=2)
        vw = lax.dynamic_slice_in_dim(vw_pad, i * QB, WINDOW + QB, axis=2)
        kpos_w = i * QB - WINDOW + jnp.arange(WINDOW + QB)
        dist_w = tq[:, None] - kpos_w[None, :]
        valid_w = (dist_w >= 0) & (dist_w < WINDOW) & (kpos_w[None, :] >= 0)
        s = jnp.einsum('bgrqd,bgkd->bgrqk', qi, kw).astype(f32)
        s = jnp.where(valid_w, s - slopes[None, :, :, None, None] * dist_w.astype(f32), NEG)
        p = jax.nn.softmax(s, axis=-1)
        o_w = jnp.einsum('bgrqk,bgkd->bgrqd', p.astype(vw.dtype), vw)
        return o_s, o_w

    o_s, o_w = lax.map(block_step, (jnp.arange(nqb), q_blocks, idx_blocks))
    o_s = jnp.moveaxis(o_s, 0, 3).reshape(B, G, R, S, Dh)
    o_w = jnp.moveaxis(o_w, 0, 3).reshape(B, G, R, S, Dh)

    g = jax.nn.sigmoid(gate_logits.astype(f32)).reshape(B, S, G, R, N_BRANCH).transpose(0, 2, 3, 1, 4)
    o = g[..., 0:1] * o_c + g[..., 1:2] * o_s + g[..., 2:3] * o_w
    return o.transpose(0, 3, 1, 2, 4).reshape(B, S, NSA_HEADS * Dh).astype(out_dtype)


def _gla(q, k, v, out_gate, gate_lr, w_gate2, b_gate, norm_w):
    B, S, _ = q.shape
    H, Dk, Dv, C = GLA_HEADS, GLA_DK, GLA_DV, GLA_CHUNK
    f32 = jnp.float32
    out_dtype = q.dtype
    log_a = jax.nn.log_sigmoid((gate_lr @ w_gate2 + b_gate).astype(f32)) / GLA_GATE_NORM
    nc = S // C

    def chunks(a, d):
        return jnp.moveaxis(a.astype(f32).reshape(B, nc, C, H, d), 1, 0).transpose(0, 1, 3, 2, 4)

    qs = chunks(q, Dk) * (Dk ** -0.5)
    ks = chunks(k, Dk)
    vs = chunks(v, Dv)
    gs = chunks(log_a, Dk)
    causal = jnp.tril(jnp.ones((C, C), dtype=bool))

    def step(state, inp):
        qc, kc, vc, gc = inp
        b = jnp.cumsum(gc, axis=2)
        o_inter = jnp.einsum('bhik,bhkv->bhiv', qc * jnp.exp(b), state)
        decay = jnp.exp(jnp.where(causal[:, :, None], b[:, :, :, None, :] - b[:, :, None, :, :], -jnp.inf))
        attn = jnp.einsum('bhik,bhjk,bhijk->bhij', qc, kc, decay)
        o_intra = jnp.einsum('bhij,bhjv->bhiv', attn, vc)
        b_last = b[:, :, -1, :]
        state = jnp.exp(b_last)[..., None] * state + jnp.einsum(
            'bhjk,bhjv->bhkv', kc * jnp.exp(b_last[:, :, None, :] - b), vc)
        return state, o_inter + o_intra

    state0 = jnp.zeros((B, H, Dk, Dv), f32)
    _, o = lax.scan(step, state0, (qs, ks, vs, gs))
    o = o.transpose(1, 0, 3, 2, 4).reshape(B, S, H, Dv)
    o = o * lax.rsqrt(jnp.mean(o * o, axis=-1, keepdims=True) + EPS) * norm_w.astype(f32)
    o = o.reshape(B, S, H * Dv) * jax.nn.silu(out_gate.astype(f32))
    return o.astype(out_dtype)


def _moe(h, w_rg, b_rg, w_re, b_re, w_gate, w_up, w_down):
    B, S, D = h.shape
    N = B * S
    NK = N * TOP_K
    f32 = jnp.float32
    xt = h.reshape(N, D)
    grp_prob = jax.nn.softmax((xt @ w_rg + b_rg).astype(f32), axis=-1)
    grp_p, grp = lax.top_k(grp_prob, 1)
    exp_logits = (xt @ w_re + b_re).astype(f32).reshape(N, N_GROUPS, EXPERTS_PER_GROUP)
    exp_logits = jnp.take_along_axis(exp_logits, grp[:, :, None], axis=1)[:, 0]
    top_v, top_i = lax.top_k(exp_logits, TOP_K)
    weight = grp_p * jax.nn.softmax(top_v, axis=-1)
    expert = grp * EXPERTS_PER_GROUP + top_i
    flat_e = expert.reshape(-1)
    flat_w = weight.reshape(-1)
    flat_tok = jnp.arange(NK) // TOP_K
    counts = jnp.zeros((N_EXPERTS,), jnp.int32).at[flat_e].add(1)
    padded = (counts + MOE_BLOCK - 1) // MOE_BLOCK * MOE_BLOCK
    pad_end = jnp.cumsum(padded)
    pad_start = pad_end - padded
    start = jnp.cumsum(counts) - counts
    order = jnp.argsort(flat_e, stable=True)
    e_sorted = flat_e[order]
    dest = pad_start[e_sorted] + jnp.arange(NK) - start[e_sorted]
    cap = ((NK + N_EXPERTS * (MOE_BLOCK - 1) + MOE_BLOCK - 1) // MOE_BLOCK) * MOE_BLOCK
    n_blk = cap // MOE_BLOCK
    slot_tok = jnp.full((cap,), N, jnp.int32).at[dest].set(flat_tok[order])
    slot_w = jnp.zeros((cap,), f32).at[dest].set(flat_w[order])
    blk_expert = jnp.minimum(jnp.searchsorted(pad_end, jnp.arange(n_blk) * MOE_BLOCK, side='right'),
                             N_EXPERTS - 1)
    x_slots = jnp.concatenate([xt, jnp.zeros((1, D), xt.dtype)], axis=0)[slot_tok]
    x_slots = x_slots.reshape(n_blk, MOE_BLOCK, D)

    def expert_ffn(args):
        xb, e = args
        return (jax.nn.silu(xb @ w_gate[e]) * (xb @ w_up[e])) @ w_down[e]

    y = lax.map(expert_ffn, (x_slots, blk_expert)).reshape(cap, D)
    y = y * slot_w[:, None].astype(y.dtype)
    y = jnp.zeros((N + 1, D), y.dtype).at[slot_tok].add(y)[:N]
    return y.reshape(B, S, D)


def setup_inputs(seed: int = 0) -> dict:
    key = jax.random.key(seed)
    ks = jax.random.split(key, 32)
    L, D, Dh = DEPTH, D_MODEL, NSA_HEAD_DIM

    def nrm(k, shape, scale):
        return jax.random.normal(k, shape, jnp.float32) * scale

    return {
        'x': nrm(ks[0], (BATCH, SEQ, D), 1.0),
        'c': nrm(ks[1], (BATCH, D), 1.0),
        'w_ada': nrm(ks[2], (L, D, 6 * D), 0.5 * D ** -0.5),
        'b_ada': nrm(ks[3], (L, 6 * D), 0.02),
        'norm1_w': 1.0 + nrm(ks[4], (L, D), 0.02),
        'w_in': nrm(ks[5], (L, D, IN_WIDTH), D ** -0.5),
        'cmp_pos_k': nrm(ks[6], (L, CMP_BLOCK, Dh), 0.1),
        'cmp_w1_k': nrm(ks[7], (L, CMP_BLOCK * Dh, Dh), (CMP_BLOCK * Dh) ** -0.5),
        'cmp_w2_k': nrm(ks[8], (L, Dh, Dh), Dh ** -0.5),
        'cmp_pos_v': nrm(ks[9], (L, CMP_BLOCK, Dh), 0.1),
        'cmp_w1_v': nrm(ks[10], (L, CMP_BLOCK * Dh, Dh), (CMP_BLOCK * Dh) ** -0.5),
        'cmp_w2_v': nrm(ks[11], (L, Dh, Dh), Dh ** -0.5),
        'gla_w_gate2': nrm(ks[12], (L, GLA_GATE_RANK, GLA_HEADS * GLA_DK), GLA_GATE_RANK ** -0.5),
        'gla_b_gate': nrm(ks[13], (L, GLA_HEADS * GLA_DK), 0.1),
        'gla_norm_w': 1.0 + nrm(ks[14], (L, GLA_DV), 0.02),
        'w_out': nrm(ks[15], (L, MIX_WIDTH, D), MIX_WIDTH ** -0.5),
        'norm2_w': 1.0 + nrm(ks[16], (L, D), 0.02),
        'w_router_group': nrm(ks[17], (L, D, N_GROUPS), D ** -0.5),
        'b_router_group': nrm(ks[18], (L, N_GROUPS), 0.01),
        'w_router_expert': nrm(ks[19], (L, D, N_EXPERTS), D ** -0.5),
        'b_router_expert': nrm(ks[20], (L, N_EXPERTS), 0.01),
        'w_expert_gate': nrm(ks[21], (L, N_EXPERTS, D, EXPERT_FF), D ** -0.5),
        'w_expert_up': nrm(ks[22], (L, N_EXPERTS, D, EXPERT_FF), D ** -0.5),
        'w_expert_down': nrm(ks[23], (L, N_EXPERTS, EXPERT_FF, D), EXPERT_FF ** -0.5),
        'norm_f_w': 1.0 + nrm(ks[24], (D,), 0.02),
    }


def reference(x, c, w_ada, b_ada, norm1_w, w_in, cmp_pos_k, cmp_w1_k, cmp_w2_k, cmp_pos_v,
              cmp_w1_v, cmp_w2_v, gla_w_gate2, gla_b_gate, gla_norm_w, w_out, norm2_w,
              w_router_group, b_router_group, w_router_expert, b_router_expert,
              w_expert_gate, w_expert_up, w_expert_down, norm_f_w):
    offsets = np.cumsum(IN_SPLITS)[:-1].tolist()
    for l in range(DEPTH):
        mod = jax.nn.silu(c) @ w_ada[l] + b_ada[l]
        sh1, sc1, g1, sh2, sc2, g2 = [m[:, None, :] for m in jnp.split(mod, 6, axis=-1)]
        h = _rmsnorm(x, norm1_w[l]) * (1.0 + sc1) + sh1
        proj = h @ w_in[l]
        nsa_q, nsa_kv, nsa_g, gla_q, gla_k, gla_v, gla_og, gla_lr = jnp.split(proj, offsets, axis=-1)
        o_nsa = _nsa(nsa_q, nsa_kv, nsa_g, cmp_pos_k[l], cmp_w1_k[l], cmp_w2_k[l],
                     cmp_pos_v[l], cmp_w1_v[l], cmp_w2_v[l])
        o_gla = _gla(gla_q, gla_k, gla_v, gla_og, gla_lr, gla_w_gate2[l], gla_b_gate[l], gla_norm_w[l])
        mix = jnp.concatenate([o_nsa, o_gla], axis=-1)
        x = x + g1 * (mix @ w_out[l])
        h = _rmsnorm(x, norm2_w[l]) * (1.0 + sc2) + sh2
        x = x + g2 * _moe(h, w_router_group[l], b_router_group[l], w_router_expert[l],
                          b_router_expert[l], w_expert_gate[l], w_expert_up[l], w_expert_down[l])
    return _rmsnorm(x, norm_f_w)
```

```cpp
#include <hip/hip_runtime.h>
#include <hip/hip_cooperative_groups.h>
#include <cstdio>
#include <cstdint>
namespace cg = cooperative_groups;
namespace pg8 {
#define PG8_LAS __attribute__((address_space(3)))
typedef unsigned short bf16_t;
typedef short bf16x8 __attribute__((ext_vector_type(8)));
typedef float f32x4 __attribute__((ext_vector_type(4)));
typedef unsigned u32x4 __attribute__((ext_vector_type(4)));
constexpr int BM = 256, BK = 64, HALF = 128, HTB = HALF * BK * 2  , STAGE_BYTES = 8 * HTB, NXCD = 8, WGM = 8;

__host__ __device__ __forceinline__ int lds_byte(int r, int c) { const int st = (r >> 4) * 2 + (c >> 5), rr = r & 15, cc = c & 31, ob = rr * 64 + cc * 2; return st * 1024 + (ob ^ (((ob >> 9) & 1) << 5)); }
__host__ __device__ __forceinline__ void stage_rc(int b, int& R, int& C) { const int st = b / 1024, sb = b % 1024, swz = sb ^ (((sb >> 9) & 1) << 5); R = (st >> 1) * 16 + swz / 64; C = (st & 1) * 32 + (swz % 64) / 2; }
__host__ __device__ __forceinline__ int perm32(int rho) { const int n = rho >> 4, i = rho & 15; return 8 * (i >> 2) + 4 * n + (i & 3); }

struct Unit { int pm, pn; };
struct Gemm { const bf16_t* A; const bf16_t* Bt; int M, N, K; };

struct StaticOrder {
    int nM, nN, nwg, G, c;
    __host__ __device__ void init(int M, int N, int G_, int c_) { nM = M / BM; nN = N / BM; nwg = nM * nN; G = G_; c = c_; }
    __host__ __device__ bool next(int i, Unit& u) const {
        const long L = (long)i * G + c; if (L >= nwg) return false;
        int wgid = (int)L; { const int q = nwg / NXCD, r = nwg % NXCD, xcd = wgid % NXCD, off = wgid / NXCD; wgid = (xcd < r ? xcd * (q + 1) : r * (q + 1) + (xcd - r) * q) + off; }
        const int nig = WGM * nN, gid = wgid / nig, fm = gid * WGM, gsz = (nM - fm) < WGM ? (nM - fm) : WGM;
        u.pm = fm + ((wgid % nig) % gsz); u.pn = (wgid % nig) / gsz; return true;
    }
    __device__ __forceinline__ void a_ready(const Unit&) const {}
    __device__ __forceinline__ void done(const Unit&) const {}
};

__device__ __forceinline__ unsigned cvt_pk_bf16(float lo, float hi) { unsigned r; asm volatile("v_cvt_pk_bf16_f32 %0, %1, %2" : "=v"(r) : "v"(lo), "v"(hi)); return r; }
typedef float f32x2 __attribute__((ext_vector_type(2)));
__device__ __forceinline__ f32x2 gelu_pk(f32x2 v) {
    const f32x2 av = __builtin_elementwise_abs(v), d = av * 0.2316418882f + 1.0f;
    f32x2 t; t.x = __builtin_amdgcn_rcpf(d.x); t.y = __builtin_amdgcn_rcpf(d.y);
    f32x2 q = t * 0.5307027145f + (-0.7265760135f); q = q * t + 0.7107068705f; q = q * t + (-0.142248368f); q = q * t + 0.127414796f; q = q * t;
    const f32x2 s = (v * v) * (-0.72134752044f);
    f32x2 e; e.x = __builtin_amdgcn_exp2f(s.x); e.y = __builtin_amdgcn_exp2f(s.y);
    const f32x2 m = v * (q * e), r = v - m;
    f32x2 o; o.x = v.x < 0.f ? m.x : r.x; o.y = v.y < 0.f ? m.y : r.y; return o;
}

template <int ACT  > struct EpiBf16 {
    static constexpr bool PERM = true, AFTER_DRAIN = false; static_assert(ACT == 0 || ACT == 1, "EpiBf16: ACT is 0 (none) or 1 (gelu_pk)");
    bf16_t* O; int ldc; const float* bias; int split_cols; size_t split_stride; float scale0;
    __device__ __forceinline__ void operator()(const f32x4 (&acc)[2][2][4][2], const Unit& u, int wr, int wc, int fr, int fq) const {
        const int row0 = u.pm * BM + wr * 64 + fr; int colt = u.pn * BM; bf16_t* base = O;
        float sc = 1.f; if (split_cols) { const int t = colt / split_cols; base += (size_t)t * split_stride; colt -= t * split_cols; if (t == 0) sc = scale0; }
        const int col0 = colt + wc * 32 + 8 * fq, bcol0 = u.pn * BM + wc * 32 + 8 * fq;
        f32x4 bv[2][2];
#pragma unroll
        for (int bj = 0; bj < 2; ++bj)
#pragma unroll
            for (int n = 0; n < 2; ++n) bv[bj][n] = bias ? *(const f32x4*)(bias + bcol0 + bj * HALF + 4 * n) : (f32x4){0.f, 0.f, 0.f, 0.f};
#pragma unroll
        for (int ai = 0; ai < 2; ++ai)
#pragma unroll
            for (int m = 0; m < 4; ++m) { bf16_t* rowp = base + (size_t)(row0 + ai * HALF + m * 16) * ldc + col0;
#pragma unroll
                for (int bj = 0; bj < 2; ++bj) { f32x4 v0 = acc[ai][bj][m][0] + bv[bj][0], v1 = acc[ai][bj][m][1] + bv[bj][1];
                    if (ACT == 1) { f32x2 a = gelu_pk((f32x2){v0[0], v0[1]}), b = gelu_pk((f32x2){v0[2], v0[3]}), c = gelu_pk((f32x2){v1[0], v1[1]}), d = gelu_pk((f32x2){v1[2], v1[3]});
                        v0 = (f32x4){a.x, a.y, b.x, b.y}; v1 = (f32x4){c.x, c.y, d.x, d.y}; }
                    v0 = v0 * sc; v1 = v1 * sc; u32x4 w; w.x = cvt_pk_bf16(v0[0], v0[1]); w.y = cvt_pk_bf16(v0[2], v0[3]); w.z = cvt_pk_bf16(v1[0], v1[1]); w.w = cvt_pk_bf16(v1[2], v1[3]);
                    *(u32x4*)(rowp + bj * HALF) = w; } }
    }
};
template <class Epi, class Sched, bool ALIGN_EPI = false, bool SP2 = false>
__device__ __forceinline__ void gemm_phase(PG8_LAS unsigned char* lds, const Gemm g, const Sched& S, const Epi& E) {
    const int tid = threadIdx.x, wid = __builtin_amdgcn_readfirstlane(tid >> 6), lane = tid & 63, wr = wid >> 2, wc = wid & 3, fr = lane & 15, fq = lane >> 4;
    const int K = g.K, nt = K / BK;
    unsigned voffA[2], voffB[2];
#pragma unroll
    for (int i = 0; i < 2; ++i) { int R, C; stage_rc(tid * 16 + i * 8192, R, C); const int Rb = Epi::PERM ? ((R & ~31) + perm32(R & 31)) : R;
        voffA[i] = (unsigned)(R * K + C) * 2u; voffB[i] = (unsigned)(Rb * K + C) * 2u; }
    const size_t kstep = (size_t)(BK * 2);
    const size_t hstep = (size_t)HALF * K * 2;
    const size_t tstep = 2 * hstep;
    const unsigned ldsw = (unsigned)wid * 1024u;
    const int aoff = lds_byte(wr * 64 + fr, fq * 8), boff = lds_byte(wc * 32 + fr, fq * 8);
#define PG8_SA(b, h) (((b) * 2 + (h)) * HTB)
#define PG8_SB(b, h) ((4 + (b) * 2 + (h)) * HTB)
#define PG8_STAGE(bufoff, gbase, voff) do { _Pragma("unroll") for (int _i = 0; _i < 2; ++_i) \
        __builtin_amdgcn_global_load_lds((const unsigned*)((const char*)(gbase) + (voff)[_i]), (PG8_LAS unsigned*)(lds + (bufoff) + ldsw + _i * 8192), 16, 0, 0); } while (0)
#define PG8_LDA(dst, b, h) do { _Pragma("unroll") for (int m = 0; m < 4; ++m) _Pragma("unroll") for (int k = 0; k < 2; ++k) dst[m][k] = *(const PG8_LAS bf16x8*)(lds + PG8_SA(b, h) + aoff + m * 2048 + k * 1024); } while (0)
#define PG8_LDB(dst, b, h) do { _Pragma("unroll") for (int n = 0; n < 2; ++n) _Pragma("unroll") for (int k = 0; k < 2; ++k) dst[n][k] = *(const PG8_LAS bf16x8*)(lds + PG8_SB(b, h) + boff + n * 2048 + k * 1024); } while (0)
#define PG8_MMA(ai, bj, At, Bt) do { __builtin_amdgcn_s_setprio(1); _Pragma("unroll") for (int m = 0; m < 4; ++m) _Pragma("unroll") for (int n = 0; n < 2; ++n) _Pragma("unroll") for (int k = 0; k < 2; ++k) \
        acc[ai][bj][m][n] = __builtin_amdgcn_mfma_f32_16x16x32_bf16(Bt[n][k], At[m][k], acc[ai][bj][m][n], 0, 0, 0); __builtin_amdgcn_s_setprio(0); } while (0)
#define PG8_WAIT_V(n) asm volatile("s_waitcnt vmcnt(" #n ")" ::: "memory")
#define PG8_WAIT_L(n) asm volatile("s_waitcnt lgkmcnt(" #n ")" ::: "memory")
#define PG8_BAR __builtin_amdgcn_s_barrier()
#define PG8_SCHED __builtin_amdgcn_sched_barrier(0)
    Unit cur, nxt; int ui = 0;
    if (!S.next(0, cur)) return;
    f32x4 acc[2][2][4][2];
#pragma unroll
    for (int a = 0; a < 2; ++a)
#pragma unroll
        for (int b = 0; b < 2; ++b)
#pragma unroll
            for (int m = 0; m < 4; ++m)
#pragma unroll
                for (int n = 0; n < 2; ++n) acc[a][b][m][n] = (f32x4){0.f, 0.f, 0.f, 0.f};
    bf16x8 At[4][2], B0[2][2], B1[2][2];
    const char* cA = (const char*)g.A + (size_t)cur.pm * tstep; const char* cB = (const char*)g.Bt + (size_t)cur.pn * tstep;
    S.a_ready(cur);
    if constexpr (SP2) {
        PG8_STAGE(PG8_SB(0, 0), cB, voffB); PG8_STAGE(PG8_SB(0, 1), cB + hstep, voffB); PG8_STAGE(PG8_SA(0, 0), cA, voffA); PG8_STAGE(PG8_SA(0, 1), cA + hstep, voffA);
        if (wr == 1) PG8_BAR;
        PG8_WAIT_V(2); PG8_BAR;
        PG8_STAGE(PG8_SB(1, 0), cB + kstep, voffB); PG8_STAGE(PG8_SA(1, 0), cA + kstep, voffA); PG8_STAGE(PG8_SB(1, 1), cB + hstep + kstep, voffB);
        PG8_WAIT_V(6); PG8_BAR;
    } else {
        PG8_STAGE(PG8_SB(0, 0), cB, voffB); PG8_STAGE(PG8_SA(0, 0), cA, voffA); PG8_STAGE(PG8_SB(0, 1), cB + hstep, voffB); PG8_STAGE(PG8_SA(0, 1), cA + hstep, voffA);
        if (wr == 1) PG8_BAR;
        PG8_WAIT_V(4); PG8_BAR;
        PG8_STAGE(PG8_SB(1, 0), cB + kstep, voffB); PG8_STAGE(PG8_SA(1, 0), cA + kstep, voffA); PG8_STAGE(PG8_SB(1, 1), cB + hstep + kstep, voffB);
        PG8_WAIT_V(6); PG8_BAR;
    }
    for (;;) {
        const bool has_next = S.next(ui + 1, nxt);
        const char* nA = has_next ? (const char*)g.A + (size_t)nxt.pm * tstep : cA; const char* nB = has_next ? (const char*)g.Bt + (size_t)nxt.pn * tstep : cB;
        for (int t = 0; t < nt; t += 2) {
            const bool last = (t == nt - 2);
            const char* a1 = cA + (size_t)(t + 1) * kstep;
            const char* a2 = last ? nA : cA + (size_t)(t + 2) * kstep; const char* b2 = last ? nB : cB + (size_t)(t + 2) * kstep;
            const char* a3 = a2 + kstep; const char* b3 = b2 + kstep;
            if (last && has_next) S.a_ready(nxt);
            if constexpr (SP2) {
            PG8_LDB(B0, 0, 0); PG8_LDB(B1, 0, 1); PG8_SCHED; PG8_LDA(At, 0, 0); PG8_STAGE(PG8_SA(1, 1), a1 + hstep, voffA);
            PG8_WAIT_V(8); PG8_WAIT_L(0); PG8_BAR; PG8_MMA(0, 0, At, B0); PG8_MMA(0, 1, At, B1); PG8_BAR; PG8_SCHED;
            PG8_LDA(At, 0, 1); PG8_STAGE(PG8_SB(0, 0), b2, voffB); PG8_STAGE(PG8_SB(0, 1), b2 + hstep, voffB); PG8_STAGE(PG8_SA(0, 0), a2, voffA);
            PG8_WAIT_V(8); PG8_WAIT_L(0); PG8_BAR; PG8_MMA(1, 0, At, B0); PG8_MMA(1, 1, At, B1); PG8_BAR; PG8_SCHED;
            PG8_LDB(B0, 1, 0); PG8_LDB(B1, 1, 1); PG8_SCHED; PG8_LDA(At, 1, 0); PG8_STAGE(PG8_SA(0, 1), a2 + hstep, voffA);
            PG8_WAIT_V(8); PG8_WAIT_L(0); PG8_BAR; PG8_MMA(0, 0, At, B0); PG8_MMA(0, 1, At, B1); PG8_BAR; PG8_SCHED;
            PG8_LDA(At, 1, 1); PG8_STAGE(PG8_SB(1, 0), b3, voffB); PG8_STAGE(PG8_SB(1, 1), b3 + hstep, voffB); PG8_STAGE(PG8_SA(1, 0), a3, voffA);
            PG8_WAIT_V(8); PG8_WAIT_L(0); PG8_BAR; PG8_MMA(1, 0, At, B0); PG8_MMA(1, 1, At, B1); PG8_BAR; PG8_SCHED;
            } else {
            PG8_LDB(B0, 0, 0); PG8_SCHED; PG8_LDA(At, 0, 0); PG8_STAGE(PG8_SA(1, 1), a1 + hstep, voffA);
            PG8_WAIT_L(8); PG8_BAR; PG8_WAIT_L(0); PG8_MMA(0, 0, At, B0); PG8_BAR; PG8_SCHED;
            PG8_LDB(B1, 0, 1); PG8_STAGE(PG8_SB(0, 0), b2, voffB);
            PG8_BAR; PG8_WAIT_L(0); PG8_MMA(0, 1, At, B1); PG8_BAR;
            PG8_LDA(At, 0, 1); PG8_STAGE(PG8_SA(0, 0), a2, voffA);
            PG8_BAR; PG8_WAIT_L(0); PG8_MMA(1, 0, At, B0); PG8_BAR; PG8_SCHED;
            PG8_STAGE(PG8_SB(0, 1), b2 + hstep, voffB);
            PG8_WAIT_V(6); PG8_BAR; PG8_MMA(1, 1, At, B1); PG8_BAR;
            PG8_LDB(B0, 1, 0); PG8_SCHED; PG8_LDA(At, 1, 0); PG8_STAGE(PG8_SA(0, 1), a2 + hstep, voffA);
            PG8_WAIT_L(8); PG8_BAR; PG8_WAIT_L(0); PG8_MMA(0, 0, At, B0); PG8_BAR; PG8_SCHED;
            PG8_LDB(B1, 1, 1); PG8_STAGE(PG8_SB(1, 0), b3, voffB);
            PG8_BAR; PG8_WAIT_L(0); PG8_MMA(0, 1, At, B1); PG8_BAR;
            PG8_LDA(At, 1, 1); PG8_STAGE(PG8_SA(1, 0), a3, voffA);
            PG8_BAR; PG8_WAIT_L(0); PG8_MMA(1, 0, At, B0); PG8_BAR; PG8_SCHED;
            PG8_STAGE(PG8_SB(1, 1), b3 + hstep, voffB);
            PG8_WAIT_V(6); PG8_BAR; PG8_MMA(1, 1, At, B1); PG8_BAR;
            }
        }
        if constexpr (ALIGN_EPI) { if (wr == 0) PG8_BAR; }
        if constexpr (!Epi::AFTER_DRAIN) { E(acc, cur, wr, wc, fr, fq); S.done(cur); }
        if (!has_next) break;
#pragma unroll
        for (int a = 0; a < 2; ++a)
#pragma unroll
            for (int b = 0; b < 2; ++b)
#pragma unroll
                for (int m = 0; m < 4; ++m)
#pragma unroll
                    for (int n = 0; n < 2; ++n) acc[a][b][m][n] = (f32x4){0.f, 0.f, 0.f, 0.f};
        cur = nxt; cA = nA; cB = nB; ++ui;
        if constexpr (ALIGN_EPI) { if (wr == 1) PG8_BAR; }
    }
    PG8_WAIT_V(0);
    if constexpr (!ALIGN_EPI) { if (wr == 0) PG8_BAR; }
    PG8_BAR;
    if constexpr (Epi::AFTER_DRAIN) { E.fused(acc, cur, wr, wc, fr, fq, lds, wid, lane); S.done(cur); }
#undef PG8_SA
#undef PG8_SB
#undef PG8_STAGE
#undef PG8_LDA
#undef PG8_LDB
#undef PG8_MMA
#undef PG8_WAIT_V
#undef PG8_WAIT_L
#undef PG8_BAR
#undef PG8_SCHED
}
}

namespace pg8 {
__device__ __forceinline__ float silu_f(float x) { return x * __builtin_amdgcn_rcpf(1.0f + __builtin_amdgcn_exp2f(-1.4426950408889634f * x)); }
struct EpiResid {
    static constexpr bool PERM = true, AFTER_DRAIN = false;
    const float* X; float* O; const float* G;
    __device__ __forceinline__ void operator()(const f32x4 (&acc)[2][2][4][2], const Unit& u, int wr, int wc, int fr, int fq) const {
        const int row0 = u.pm * BM + wr * 64 + fr, col0 = u.pn * BM + wc * 32 + 8 * fq;
        const int b = (u.pm * BM) >> 11;
        const float* gp = G + (size_t)b * 12288 + col0;
        f32x4 gv[2][2];
#pragma unroll
        for (int bj = 0; bj < 2; ++bj)
#pragma unroll
            for (int n = 0; n < 2; ++n) gv[bj][n] = *(const f32x4*)(gp + bj * HALF + 4 * n);
#pragma unroll
        for (int ai = 0; ai < 2; ++ai)
#pragma unroll
            for (int m = 0; m < 4; ++m) { const size_t off = (size_t)(row0 + ai * HALF + m * 16) * 2048 + col0;
#pragma unroll
                for (int bj = 0; bj < 2; ++bj)
#pragma unroll
                    for (int n = 0; n < 2; ++n) { const f32x4 xv = *(const f32x4*)(X + off + bj * HALF + 4 * n); const f32x4 o = xv + gv[bj][n] * acc[ai][bj][m][n]; *(f32x4*)(O + off + bj * HALF + 4 * n) = o; } }
    }
};
struct EpiSwiGLU {
    static constexpr bool PERM = true, AFTER_DRAIN = false;
    bf16_t* Hm;
    __device__ __forceinline__ void operator()(const f32x4 (&acc)[2][2][4][2], const Unit& u, int wr, int wc, int fr, int fq) const {
        const int t = u.pn & 3; const int row0 = u.pm * BM + wr * 64 + fr, col0 = t * 128 + wc * 32 + 8 * fq;
#pragma unroll
        for (int ai = 0; ai < 2; ++ai)
#pragma unroll
            for (int m = 0; m < 4; ++m) { bf16_t* rowp = Hm + (size_t)(row0 + ai * HALF + m * 16) * 512 + col0;
                const f32x4 g0 = acc[ai][0][m][0], g1 = acc[ai][0][m][1], u0 = acc[ai][1][m][0], u1 = acc[ai][1][m][1];
                u32x4 w; w.x = cvt_pk_bf16(silu_f(g0[0]) * u0[0], silu_f(g0[1]) * u0[1]); w.y = cvt_pk_bf16(silu_f(g0[2]) * u0[2], silu_f(g0[3]) * u0[3]);
                w.z = cvt_pk_bf16(silu_f(g1[0]) * u1[0], silu_f(g1[1]) * u1[1]); w.w = cvt_pk_bf16(silu_f(g1[2]) * u1[2], silu_f(g1[3]) * u1[3]);
                *(u32x4*)rowp = w; }
    }
};
struct EpiDown {
    static constexpr bool PERM = true, AFTER_DRAIN = false;
    bf16_t* Y; const int* slot_tok; const float* slot_w;
    __device__ __forceinline__ void operator()(const f32x4 (&acc)[2][2][4][2], const Unit& u, int wr, int wc, int fr, int fq) const {
        const int t = u.pn & 7; const int row0 = u.pm * BM + wr * 64 + fr, col0 = t * 256 + wc * 32 + 8 * fq;
#pragma unroll
        for (int ai = 0; ai < 2; ++ai)
#pragma unroll
            for (int m = 0; m < 4; ++m) { const int slot = row0 + ai * HALF + m * 16; const int st = slot_tok[slot];
                if (st >= 0) { const float w = slot_w[slot]; bf16_t* rowp = Y + (size_t)st * 2048 + col0;
#pragma unroll
                    for (int bj = 0; bj < 2; ++bj) { const f32x4 v0 = acc[ai][bj][m][0] * w, v1 = acc[ai][bj][m][1] * w;
                        u32x4 o; o.x = cvt_pk_bf16(v0[0], v0[1]); o.y = cvt_pk_bf16(v0[2], v0[3]); o.z = cvt_pk_bf16(v1[0], v1[1]); o.w = cvt_pk_bf16(v1[2], v1[3]);
                        *(u32x4*)(rowp + bj * HALF) = o; } } }
    }
};
struct GroupedOrder {
    const int* rbe; int nunits, NT, G, c;
    __device__ __forceinline__ bool next(int i, Unit& u) const {
        const long L = (long)i * G + c; if (L >= nunits) return false;
        const int rb = (int)(L / NT), t = (int)(L % NT);
        const int e = __hip_atomic_load(rbe + rb, __ATOMIC_RELAXED, __HIP_MEMORY_SCOPE_AGENT);
        u.pm = rb; u.pn = e * NT + t; return true;
    }
    __device__ __forceinline__ void a_ready(const Unit&) const {}
    __device__ __forceinline__ void done(const Unit&) const {}
};
}

using pg8::bf16_t; using pg8::bf16x8; using pg8::f32x4; using pg8::u32x4;
typedef float f32x16 __attribute__((ext_vector_type(16)));
typedef short s16x4 __attribute__((ext_vector_type(4)));
typedef unsigned u32x2 __attribute__((ext_vector_type(2)));
#define LAS __attribute__((address_space(3)))

constexpr int NTHREADS = 512, NWAVES = 8;
constexpr int LDS_BYTES = 147456;
constexpr int DM = 2048, NTOK = 8192, SEQ = 2048, NB = 4;
constexpr int PW = 5888;
constexpr int PC_Q = 0, PC_KC = 1024, PC_VC = 1280, PC_KS = 1536, PC_VS = 1792, PC_KW = 2048, PC_VW = 2304;
constexpr int PC_GQ = 2560, PC_GK = 3072, PC_GV = 3584, PC_GO = 4608, PC_GATE = 5632, PC_LR = 5680;
constexpr int NKC = 16;
constexpr int CAP = 24576;
constexpr float LOG2E = 1.4426950408889634f;
constexpr float EPS = 1e-6f;

constexpr size_t MiB = 1u << 20;
constexpr size_t WS_CTL = 0, CTL_ZERO_BYTES = 64 * 1024;
constexpr size_t WS_MODP = 1 * MiB;
constexpr size_t WS_MODF = 5 * MiB;
constexpr size_t WS_A2G = WS_MODF + 256 * 1024;
constexpr size_t WS_SH2G = WS_A2G + 64 * 1024;
constexpr size_t WS_SMALL = 6 * MiB;
constexpr size_t WS_W1TK = WS_SMALL;
constexpr size_t WS_W1TV = WS_W1TK + 256 * 1024;
constexpr size_t WS_W2TK = WS_W1TV + 256 * 1024;
constexpr size_t WS_W2TV = WS_W2TK + 8 * 1024;
constexpr size_t WS_POSW1 = WS_W2TV + 8 * 1024;
constexpr size_t WS_KC = WS_POSW1 + 4 * 1024;
constexpr size_t WS_VCT = WS_KC + 256 * 1024;
constexpr size_t WS_WRH = WS_VCT + 256 * 1024;
constexpr size_t WS_WRL = WS_WRH + 192 * 1024;
constexpr size_t WS_ROUTE = 8 * MiB;
constexpr size_t WS_TOKE = WS_ROUTE;
constexpr size_t WS_TOKW = WS_TOKE + 64 * 1024;
constexpr size_t WS_TOKP = WS_TOKW + 64 * 1024;
constexpr size_t WS_SLOTT = WS_TOKP + 64 * 1024;
constexpr size_t WS_SLOTW = WS_SLOTT + 128 * 1024;
constexpr size_t WS_RBE = WS_SLOTW + 128 * 1024;
constexpr size_t WS_WIN = 10 * MiB;
constexpr size_t WS_WOUT = 33 * MiB;
constexpr size_t WS_WGU = 41 * MiB;
constexpr size_t WS_WD = 169 * MiB;
constexpr size_t WS_H = 233 * MiB;
constexpr size_t WS_P = 265 * MiB;
constexpr size_t WS_OW = 361 * MiB;
constexpr size_t WS_HMID = 377 * MiB;
constexpr size_t WS_END = 401 * MiB;
constexpr int CW_Q3 = 64, CW_Q4 = 128, CW_ECNT = 256;

struct Params { const float* in[25]; float* out; unsigned char* ws; };

__device__ __forceinline__ float bf2f(unsigned short v) { return __uint_as_float((unsigned)v << 16); }
__device__ __forceinline__ unsigned pk2(float lo, float hi) {
    typedef float f2_t __attribute__((ext_vector_type(2))); typedef __bf16 b2_t __attribute__((ext_vector_type(2)));
    f2_t v = {lo, hi}; b2_t b = __builtin_convertvector(v, b2_t); return __builtin_bit_cast(unsigned, b);
}
__device__ __forceinline__ unsigned short f2bf(float f) { return (unsigned short)(pk2(f, 0.f) & 0xffffu); }
__device__ __forceinline__ float wave_sum(float v) {
#pragma unroll
    for (int o = 1; o < 64; o <<= 1) v += __shfl_xor(v, o);
    return v;
}
__device__ __forceinline__ float fexp2(float x) { return __builtin_amdgcn_exp2f(x); }
__device__ __forceinline__ float fexp(float x) { return __builtin_amdgcn_exp2f(x * LOG2E); }
__device__ __forceinline__ float sigmoid_f(float x) { return __builtin_amdgcn_rcpf(1.0f + fexp(-x)); }
__device__ __forceinline__ f32x16 mfma32(bf16x8 a, bf16x8 b, f32x16 c) { return __builtin_amdgcn_mfma_f32_32x32x16_bf16(a, b, c, 0, 0, 0); }
__device__ __forceinline__ f32x4 mfma16(bf16x8 a, bf16x8 b, f32x4 c) { return __builtin_amdgcn_mfma_f32_16x16x32_bf16(a, b, c, 0, 0, 0); }
__device__ __forceinline__ bf16x8 cat4(s16x4 a, s16x4 b) { return (bf16x8){a[0], a[1], a[2], a[3], b[0], b[1], b[2], b[3]}; }

template <class Map>
__device__ __forceinline__ void tr_item(const float* __restrict__ W, int K, int N, int k0, int n0, bf16_t* WT, const Map& map, float* scr, int lane) {
#pragma unroll 8
    for (int i = 0; i < 32; ++i) { const int kk = 2 * i + (lane >> 5); scr[kk * 33 + (lane & 31)] = W[(size_t)(k0 + kk) * N + n0 + (lane & 31)]; }
    asm volatile("s_waitcnt lgkmcnt(0)" ::: "memory");
    const int c = lane & 7;
#pragma unroll
    for (int j = 0; j < 4; ++j) { const int n = (lane >> 3) + 8 * j; const float* s = scr + (8 * c) * 33 + n; const int row = map(n0 + n);
        u32x4 o; o.x = pk2(s[0 * 33], s[1 * 33]); o.y = pk2(s[2 * 33], s[3 * 33]); o.z = pk2(s[4 * 33], s[5 * 33]); o.w = pk2(s[6 * 33], s[7 * 33]);
        if (row >= 0) *(u32x4*)(WT + (size_t)row * K + k0 + 8 * c) = o; }
    asm volatile("s_waitcnt lgkmcnt(0)" ::: "memory");
}
struct MapIn { __device__ __forceinline__ int operator()(int oc) const {
    if (oc < 2560) return oc; if (oc < 2608) return oc - 2560 + PC_GATE; if (oc < 5680) return oc - 48; return oc; } };
struct MapOff { int off; __device__ __forceinline__ int operator()(int n) const { return off + n; } };
struct MapGU { int base; __device__ __forceinline__ int operator()(int n) const { return base + (n >> 7) * 256 + (n & 127); } };

__device__ __forceinline__ void p0_prologue(const Params& p, unsigned char* lds, int tid, int lane, int wave) {
    const int G = gridDim.x, gw = blockIdx.x * NWAVES + wave, NGW = G * NWAVES;
    unsigned char* ws = p.ws;
    float* scr = (float*)(lds + wave * 8448);
    float* SC = (float*)(lds + 69632);
    for (int i = tid; i < 4 * 2048; i += NTHREADS) { const float v = p.in[1][i]; SC[i] = v * sigmoid_f(v); }
    __syncthreads();
    constexpr int nGEMV = NKC * 48, nTin = 32 * 178, nTout = 32 * 64, nTg = 32 * 32 * 16, nTd = 32 * 8 * 64, nTc1 = 64, nTc2 = 2, nZero = 192, nPos = 2;
    constexpr int nTotal = nGEMV + nTin + nTout + 2 * nTg + nTd + 2 * nTc1 + 2 * nTc2 + nZero + nPos;
    for (int it = gw; it < nTotal; it += NGW) {
        int r = it;
        if (r < nGEMV) {
            const int cgp = r % 48, kc = r / 48; const int col = cgp * 256 + lane * 4; const float* W = p.in[2] + (size_t)(kc * 128) * 12288 + col;
            f32x4 a0 = {0, 0, 0, 0}, a1 = a0, a2 = a0, a3 = a0;
#pragma unroll 8
            for (int kk = 0; kk < 128; ++kk) { const f32x4 w = *(const f32x4*)(W + (size_t)kk * 12288); const int k = kc * 128 + kk;
                a0 += w * SC[k]; a1 += w * SC[2048 + k]; a2 += w * SC[4096 + k]; a3 += w * SC[6144 + k]; }
            float* mp = (float*)(ws + WS_MODP) + (size_t)kc * 4 * 12288 + col;
            *(f32x4*)(mp) = a0; *(f32x4*)(mp + 12288) = a1; *(f32x4*)(mp + 2 * 12288) = a2; *(f32x4*)(mp + 3 * 12288) = a3;
            continue; }
        r -= nGEMV;
        if (r < nTin) { const int kb = r / 178, nb = r % 178; tr_item(p.in[5], 2048, 5696, 64 * kb, 32 * nb, (bf16_t*)(ws + WS_WIN), MapIn{}, scr, lane); continue; }
        r -= nTin;
        if (r < nTout) { const int kb = r / 64, nb = r % 64; tr_item(p.in[15], 2048, 2048, 64 * kb, 32 * nb, (bf16_t*)(ws + WS_WOUT), MapOff{0}, scr, lane); continue; }
        r -= nTout;
        if (r < 2 * nTg) { const int up = r / nTg; r -= up * nTg; const int e = r / 512, q = r % 512, kb = q / 16, nb = q % 16;
            tr_item(p.in[21 + up] + (size_t)e * 2048 * 512, 2048, 512, 64 * kb, 32 * nb, (bf16_t*)(ws + WS_WGU), MapGU{e * 1024 + up * 128}, scr, lane); continue; }
        r -= 2 * nTg;
        if (r < nTd) { const int e = r / 512, q = r % 512, kb = q / 64, nb = q % 64;
            tr_item(p.in[23] + (size_t)e * 512 * 2048, 512, 2048, 64 * kb, 32 * nb, (bf16_t*)(ws + WS_WD), MapOff{e * 2048}, scr, lane); continue; }
        r -= nTd;
        if (r < 2 * nTc1) { const int v = r / nTc1; r -= v * nTc1; const int kb = r / 2, nb = r % 2;
            tr_item(p.in[v ? 10 : 7], 2048, 64, 64 * kb, 32 * nb, (bf16_t*)(ws + (v ? WS_W1TV : WS_W1TK)), MapOff{0}, scr, lane); continue; }
        r -= 2 * nTc1;
        if (r < 2 * nTc2) { const int v = r / nTc2, nb = r % nTc2;
            tr_item(p.in[v ? 11 : 8], 64, 64, 0, 32 * nb, (bf16_t*)(ws + (v ? WS_W2TV : WS_W2TK)), MapOff{0}, scr, lane); continue; }
        r -= 2 * nTc2;
        if (r < nZero) { u32x4* z = (u32x4*)((bf16_t*)(ws + WS_WIN) + (size_t)(5696 + r) * 2048);
#pragma unroll
            for (int j = 0; j < 4; ++j) z[lane + 64 * j] = (u32x4){0u, 0u, 0u, 0u};
            continue; }
        r -= nZero;
        {
            const int v = r; const float* pos = p.in[v ? 9 : 6]; const float* w1 = p.in[v ? 10 : 7]; float s = 0.f;
            for (int k = 0; k < 2048; ++k) s += pos[k] * w1[(size_t)k * 64 + lane];
            ((float*)(ws + WS_POSW1))[v * 64 + lane] = s; }
    }
    { bf16_t* WH = (bf16_t*)(ws + WS_WRH); bf16_t* WL = (bf16_t*)(ws + WS_WRL);
      for (int idx = blockIdx.x * NTHREADS + tid; idx < 48 * 2048; idx += G * NTHREADS) { const int n = idx >> 11, k = idx & 2047;
          float w = 0.f; if (n < 32) w = p.in[19][(size_t)k * 32 + n]; else if (n < 36) w = p.in[17][(size_t)k * 4 + (n - 32)];
          const unsigned short h = f2bf(w); WH[idx] = h; WL[idx] = f2bf(w - bf2f(h)); } }
}

__device__ __forceinline__ void p1_norm1(const Params& p, unsigned char* lds, int tid, int lane, int wave) {
    unsigned char* ws = p.ws; const float* MODP = (const float*)(ws + WS_MODP); const float* bada = p.in[3];
    float* A1 = (float*)lds; float* SH1 = A1 + 2048;
    for (int rbk = blockIdx.x; rbk < 256; rbk += gridDim.x) {
        const int b = rbk >> 6;
        __syncthreads();
        for (int k = tid; k < 2048; k += NTHREADS) { float sh = bada[k], sc = bada[2048 + k];
            for (int kc = 0; kc < NKC; ++kc) { const float* mp = MODP + ((size_t)kc * 4 + b) * 12288; sh += mp[k]; sc += mp[2048 + k]; }
            A1[k] = p.in[4][k] * (1.0f + sc); SH1[k] = sh; }
        if (tid < 192) { const int idx = rbk * 192 + tid; const int bb = idx / 12288, j = idx % 12288; float s = bada[j];
            for (int kc = 0; kc < NKC; ++kc) s += MODP[((size_t)kc * 4 + bb) * 12288 + j];
            ((float*)(ws + WS_MODF))[idx] = s;
            if (j >= 6144 && j < 8192) ((float*)(ws + WS_SH2G))[bb * 2048 + (j - 6144)] = s;
            if (j >= 8192 && j < 10240) ((float*)(ws + WS_A2G))[bb * 2048 + (j - 8192)] = p.in[16][j - 8192] * (1.0f + s); }
        __syncthreads();
        for (int i = 0; i < 4; ++i) { const int row = rbk * 32 + wave * 4 + i; const f32x4* xr = (const f32x4*)(p.in[0] + (size_t)row * DM) + lane;
            f32x4 v[8]; float s = 0.f;
#pragma unroll
            for (int j = 0; j < 8; ++j) { v[j] = xr[64 * j]; s += (v[j].x * v[j].x + v[j].y * v[j].y) + (v[j].z * v[j].z + v[j].w * v[j].w); }
            const float rstd = rsqrtf(wave_sum(s) * (1.0f / DM) + EPS);
            u32x2* o = (u32x2*)((bf16_t*)(ws + WS_H) + (size_t)row * DM) + lane;
#pragma unroll
            for (int j = 0; j < 8; ++j) { const int k = 4 * lane + 256 * j; const f32x4 a = *(const f32x4*)(A1 + k), sh = *(const f32x4*)(SH1 + k);
                const f32x4 h = v[j] * rstd * a + sh; u32x2 w; w.x = pk2(h.x, h.y); w.y = pk2(h.z, h.w); o[64 * j] = w; } }
    }
}

__device__ __forceinline__ int fetch_item(unsigned* ctr, volatile int* slot, int tid) {
    __syncthreads();
    if (tid == 0) *slot = (int)atomicAdd(ctr, 1u);
    __syncthreads();
    return *slot;
}

constexpr int KSTR = 72;
constexpr float ATT_C1 = 0.125f * LOG2E;

template <int VSTR>
__device__ __forceinline__ void pv_acc(const bf16_t* Vt, int kvo, const f32x16& pt, int l31, int hi, f32x16& o0, f32x16& o1) {
#pragma unroll
    for (int s = 0; s < 2; ++s) {
        u32x4 pw; pw.x = pk2(pt[8 * s + 0], pt[8 * s + 1]); pw.y = pk2(pt[8 * s + 2], pt[8 * s + 3]); pw.z = pk2(pt[8 * s + 4], pt[8 * s + 5]); pw.w = pk2(pt[8 * s + 6], pt[8 * s + 7]);
        const bf16x8 pb = __builtin_bit_cast(bf16x8, pw);
        const bf16_t* v0 = Vt + (size_t)l31 * VSTR + kvo + 16 * s + 4 * hi;
        const bf16_t* v1 = v0 + 32 * VSTR;
        const bf16x8 a0 = cat4(*(const s16x4*)v0, *(const s16x4*)(v0 + 8));
        const bf16x8 a1 = cat4(*(const s16x4*)v1, *(const s16x4*)(v1 + 8));
        o0 = mfma32(a0, pb, o0); o1 = mfma32(a1, pb, o1);
    }
}
__device__ __forceinline__ void attn_tile_update(const bf16_t* Ks, const bf16_t* Vt, const bf16x8 (&qf)[4], int l31, int hi,
                                                 float dist0, float kscale, float dlo, float dhi, bool laneok, float slope2,
                                                 f32x16& o0, f32x16& o1, float& m, float& l) {
    f32x16 s0, s1;
#pragma unroll
    for (int r = 0; r < 16; ++r) { s0[r] = 0.f; s1[r] = 0.f; }
#pragma unroll
    for (int ks = 0; ks < 4; ++ks) {
        const bf16x8 a0 = *(const bf16x8*)(Ks + l31 * KSTR + ks * 16 + hi * 8);
        const bf16x8 a1 = *(const bf16x8*)(Ks + (32 + l31) * KSTR + ks * 16 + hi * 8);
        s0 = mfma32(a0, qf[ks], s0); s1 = mfma32(a1, qf[ks], s1);
    }
    const float dbase = dist0 - kscale * (float)(4 * hi);
    float mt = -1e30f;
#pragma unroll
    for (int r = 0; r < 16; ++r) { const float c = (float)((r & 3) + 8 * (r >> 2));
        const float d0 = dbase - kscale * c, d1 = d0 - kscale * 32.0f;
        const float v0 = s0[r] * ATT_C1 - slope2 * d0, v1 = s1[r] * ATT_C1 - slope2 * d1;
        const bool ok0 = laneok && (d0 >= dlo) && (d0 < dhi), ok1 = laneok && (d1 >= dlo) && (d1 < dhi);
        s0[r] = ok0 ? v0 : -1e30f; s1[r] = ok1 ? v1 : -1e30f;
        mt = fmaxf(mt, fmaxf(s0[r], s1[r])); }
    mt = fmaxf(mt, __shfl_xor(mt, 32));
    const float mnew = fmaxf(m, mt); const float alpha = fexp2(m - mnew); m = mnew;
    float ps = 0.f;
#pragma unroll
    for (int r = 0; r < 16; ++r) { const float p0 = s0[r] > -1e29f ? fexp2(s0[r] - mnew) : 0.f, p1 = s1[r] > -1e29f ? fexp2(s1[r] - mnew) : 0.f;
        s0[r] = p0; s1[r] = p1; ps += p0 + p1; }
    l = l * alpha + ps;
#pragma unroll
    for (int r = 0; r < 16; ++r) { o0[r] *= alpha; o1[r] *= alpha; }
    pv_acc<KSTR>(Vt, 0, s0, l31, hi, o0, o1);
    pv_acc<KSTR>(Vt, 32, s1, l31, hi, o0, o1);
}
__device__ __forceinline__ void stage_kv(const bf16_t* kg, const bf16_t* vg, size_t pitch, bf16_t* Ks, bf16_t* Vt, int tid) {
    const int skv = tid >> 3, sp = tid & 7;
    const bf16x8 kreg = *(const bf16x8*)(kg + (size_t)skv * pitch + sp * 8);
    const bf16x8 vreg = *(const bf16x8*)(vg + (size_t)skv * pitch + sp * 8);
    __syncthreads();
    *(bf16x8*)(Ks + skv * KSTR + sp * 8) = kreg;
#pragma unroll
    for (int jj = 0; jj < 8; ++jj) Vt[(sp * 8 + jj) * KSTR + skv] = (bf16_t)vreg[jj];
    __syncthreads();
}

__device__ __forceinline__ void nsa_window_unit(const Params& p, unsigned char* lds, int b, int g, int qblk, int tid, int lane, int wave) {
    const bf16_t* P = (const bf16_t*)(p.ws + WS_P);
    bf16_t* Ks = (bf16_t*)lds; bf16_t* Vt = Ks + 64 * KSTR;
    const int l31 = lane & 31, hi = lane >> 5, r = wave >> 1, qh = wave & 1, h = 4 * g + r;
    const int tq = 64 * qblk + 32 * qh + l31; const size_t row = (size_t)b * SEQ + tq;
    const bf16_t* qp = P + row * PW + PC_Q + h * 64;
    bf16x8 qf[4];
#pragma unroll
    for (int ks = 0; ks < 4; ++ks) qf[ks] = *(const bf16x8*)(qp + 16 * ks + 8 * hi);
    const float slope2 = exp2f(-0.5f * (float)(h + 1)) * LOG2E;
    f32x16 o0, o1;
#pragma unroll
    for (int i = 0; i < 16; ++i) { o0[i] = 0.f; o1[i] = 0.f; }
    float m = -1e30f, l = 0.f;
    const int j0 = qblk > 8 ? qblk - 8 : 0;
    for (int j = j0; j <= qblk; ++j) {
        const bf16_t* kg = P + ((size_t)b * SEQ + 64 * j) * PW + PC_KW + g * 64;
        stage_kv(kg, kg + (PC_VW - PC_KW), PW, Ks, Vt, tid);
        attn_tile_update(Ks, Vt, qf, l31, hi, (float)(tq - 64 * j), 1.0f, 0.0f, 512.0f, true, slope2, o0, o1, m, l);
    }
    l += __shfl_xor(l, 32);
    const float gate = sigmoid_f(bf2f(P[row * PW + PC_GATE + h * 3 + 2]));
    const float sc = gate / l;
    bf16_t* ow = (bf16_t*)(p.ws + WS_OW) + row * 1024 + h * 64;
#pragma unroll
    for (int c4 = 0; c4 < 4; ++c4) { const int d = 8 * c4 + 4 * hi;
        u32x2 w0; w0.x = pk2(o0[4 * c4] * sc, o0[4 * c4 + 1] * sc); w0.y = pk2(o0[4 * c4 + 2] * sc, o0[4 * c4 + 3] * sc); *(u32x2*)(ow + d) = w0;
        u32x2 w1; w1.x = pk2(o1[4 * c4] * sc, o1[4 * c4 + 1] * sc); w1.y = pk2(o1[4 * c4 + 2] * sc, o1[4 * c4 + 3] * sc); *(u32x2*)(ow + 32 + d) = w1; }
}

__device__ __forceinline__ void nsa_cmp_sel_unit(const Params& p, unsigned char* lds, int b, int g, int qblk, int tid, int lane, int wave) {
    const bf16_t* P = (const bf16_t*)(p.ws + WS_P);
    bf16_t* Ks = (bf16_t*)lds; bf16_t* Vt = Ks + 64 * KSTR;
    bf16_t* KsC = (bf16_t*)(lds + 18432); bf16_t* VtC = (bf16_t*)(lds + 18432 + 128 * KSTR * 2);
    float* Gs = (float*)(lds + 55296); float* Ls = Gs + 4 * 64 * 32; float* IMP = Ls + 4 * 64 * 32; unsigned* SELM = (unsigned*)(IMP + 64 * 32);
    const int l31 = lane & 31, hi = lane >> 5, r = wave >> 1, qh = wave & 1, h = 4 * g + r, ql = 32 * qh + l31;
    const int tq = 64 * qblk + ql; const size_t row = (size_t)b * SEQ + tq;
    const bf16_t* qp = P + row * PW + PC_Q + h * 64;
    bf16x8 qf[4];
#pragma unroll
    for (int ks = 0; ks < 4; ++ks) qf[ks] = *(const bf16x8*)(qp + 16 * ks + 8 * hi);
    const float slope2 = exp2f(-0.5f * (float)(h + 1)) * LOG2E;
    const float g_c = sigmoid_f(bf2f(P[row * PW + PC_GATE + h * 3 + 0])), g_s = sigmoid_f(bf2f(P[row * PW + PC_GATE + h * 3 + 1]));
    f32x16 acc0, acc1;
    {
        const bf16_t* kc = (const bf16_t*)(p.ws + WS_KC) + (size_t)(b * 4 + g) * 128 * 64;
        const bf16_t* vct = (const bf16_t*)(p.ws + WS_VCT) + (size_t)(b * 4 + g) * 64 * 128;
        __syncthreads();
        for (int i = tid; i < 1024; i += NTHREADS) { const int n = i >> 3, sp = i & 7; *(bf16x8*)(KsC + n * KSTR + sp * 8) = *(const bf16x8*)(kc + n * 64 + sp * 8); }
        for (int i = tid; i < 1024; i += NTHREADS) { const int d = i >> 4, sp = i & 15; *(bf16x8*)(VtC + d * 136 + sp * 8) = *(const bf16x8*)(vct + d * 128 + sp * 8); }
        __syncthreads();
        f32x16 s[4];
#pragma unroll
        for (int t = 0; t < 4; ++t) {
#pragma unroll
            for (int i = 0; i < 16; ++i) s[t][i] = 0.f;
#pragma unroll
            for (int ks = 0; ks < 4; ++ks) { const bf16x8 a = *(const bf16x8*)(KsC + (32 * t + l31) * KSTR + ks * 16 + hi * 8); s[t] = mfma32(a, qf[ks], s[t]); } }
        const float dbase = (float)tq - 15.5f - 64.0f * (float)hi;
        float mt = -1e30f;
#pragma unroll
        for (int t = 0; t < 4; ++t)
#pragma unroll
            for (int i = 0; i < 16; ++i) { const float c = (float)(32 * t + (i & 3) + 8 * (i >> 2)); const float d = dbase - 16.0f * c;
                const float v = s[t][i] * ATT_C1 - slope2 * d; s[t][i] = (d >= 15.5f) ? v : -1e30f; mt = fmaxf(mt, s[t][i]); }
        mt = fmaxf(mt, __shfl_xor(mt, 32));
        float ps = 0.f;
#pragma unroll
        for (int t = 0; t < 4; ++t)
#pragma unroll
            for (int i = 0; i < 16; ++i) { const float pv = s[t][i] > -1e29f ? fexp2(s[t][i] - mt) : 0.f; s[t][i] = pv; ps += pv; }
        ps += __shfl_xor(ps, 32);
        const float linv = ps > 0.f ? 1.0f / ps : 0.f;
#pragma unroll
        for (int t = 0; t < 4; ++t)
#pragma unroll
            for (int i = 0; i < 16; ++i) s[t][i] *= linv;
#pragma unroll
        for (int t = 0; t < 4; ++t)
#pragma unroll
            for (int c4 = 0; c4 < 4; ++c4) { const int jj = 8 * t + 2 * c4 + hi; const int o = (r * 64 + ql) * 32 + jj;
                Gs[o] = (s[t][4 * c4] + s[t][4 * c4 + 1]) + (s[t][4 * c4 + 2] + s[t][4 * c4 + 3]); Ls[o] = s[t][4 * c4 + 3]; }
        f32x16 o0, o1;
#pragma unroll
        for (int i = 0; i < 16; ++i) { o0[i] = 0.f; o1[i] = 0.f; }
#pragma unroll
        for (int t = 0; t < 4; ++t) pv_acc<136>(VtC, 32 * t, s[t], l31, hi, o0, o1);
#pragma unroll
        for (int i = 0; i < 16; ++i) { acc0[i] = g_c * o0[i]; acc1[i] = g_c * o1[i]; }
    }
    __syncthreads();
    for (int idx = tid; idx < 64 * 32; idx += NTHREADS) { const int q = idx >> 5, j = idx & 31; float v = 0.f;
#pragma unroll
        for (int hh = 0; hh < 4; ++hh) { v += Gs[(hh * 64 + q) * 32 + j]; if (j > 0) v += Ls[(hh * 64 + q) * 32 + j - 1]; }
        IMP[idx] = v; }
    __syncthreads();
#pragma unroll 1
    for (int it = 0; it < 4; ++it) { const int q = 2 * (8 * it + wave) + (lane >> 5), j = lane & 31; bool sel;
        if (qblk < 16) sel = (j <= qblk);
        else { const bool forced = (j == 0) || (j == qblk) || (j == qblk - 1); const bool cand = (j >= 1) && (j <= qblk - 2);
            const float v = IMP[q * 32 + j]; int rank = 0;
            for (int j2 = 1; j2 <= qblk - 2; ++j2) { const float v2 = IMP[q * 32 + j2]; rank += (v2 > v || (v2 == v && j2 < j)) ? 1 : 0; }
            sel = forced || (cand && rank < 13); }
        const unsigned long long bm = __ballot(sel);
        if (j == 0) SELM[q] = (lane >> 5) ? (unsigned)(bm >> 32) : (unsigned)bm; }
    __syncthreads();
    unsigned um = 0u;
    for (int i = 0; i < 64; ++i) um |= SELM[i];
    const unsigned mymask = SELM[ql];
    {
        f32x16 o0, o1;
#pragma unroll
        for (int i = 0; i < 16; ++i) { o0[i] = 0.f; o1[i] = 0.f; }
        float m = -1e30f, l = 0.f;
        for (int j = 0; j <= qblk; ++j) {
            if (!((um >> j) & 1u)) continue;
            const bf16_t* kg = P + ((size_t)b * SEQ + 64 * j) * PW + PC_KS + g * 64;
            stage_kv(kg, kg + (PC_VS - PC_KS), PW, Ks, Vt, tid);
            attn_tile_update(Ks, Vt, qf, l31, hi, (float)(tq - 64 * j), 1.0f, 0.0f, 1e9f, ((mymask >> j) & 1u) != 0u, slope2, o0, o1, m, l);
        }
        l += __shfl_xor(l, 32);
        const float sc = g_s / l;
#pragma unroll
        for (int i = 0; i < 16; ++i) { acc0[i] += sc * o0[i]; acc1[i] += sc * o1[i]; }
    }
    const bf16_t* ow = (const bf16_t*)(p.ws + WS_OW) + row * 1024 + h * 64;
    bf16_t* mx = (bf16_t*)(p.ws + WS_H) + row * DM + h * 64;
#pragma unroll
    for (int c4 = 0; c4 < 4; ++c4) { const int d = 8 * c4 + 4 * hi;
        const u32x2 a = *(const u32x2*)(ow + d), bq = *(const u32x2*)(ow + 32 + d);
        const float w0 = acc0[4 * c4] + __uint_as_float(a.x << 16), w1 = acc0[4 * c4 + 1] + __uint_as_float(a.x & 0xffff0000u), w2 = acc0[4 * c4 + 2] + __uint_as_float(a.y << 16), w3 = acc0[4 * c4 + 3] + __uint_as_float(a.y & 0xffff0000u);
        const float x0 = acc1[4 * c4] + __uint_as_float(bq.x << 16), x1 = acc1[4 * c4 + 1] + __uint_as_float(bq.x & 0xffff0000u), x2 = acc1[4 * c4 + 2] + __uint_as_float(bq.y << 16), x3 = acc1[4 * c4 + 3] + __uint_as_float(bq.y & 0xffff0000u);
        u32x2 o; o.x = pk2(w0, w1); o.y = pk2(w2, w3); *(u32x2*)(mx + d) = o;
        u32x2 o2; o2.x = pk2(x0, x1); o2.y = pk2(x2, x3); *(u32x2*)(mx + 32 + d) = o2; }
}

__device__ __forceinline__ float gelu_tanh(float x) { const float u = 0.7978845608028654f * (x + 0.044715f * x * x * x); const float e = fexp(2.0f * u); return 0.5f * x * (2.0f - 2.0f / (e + 1.0f)); }
__device__ __forceinline__ void nsa_compress_unit(const Params& p, unsigned char* lds, int cu, int tid, int lane, int wave) {
    const int kv = cu >> 7, b = (cu >> 5) & 3, g = (cu >> 3) & 3, nt = cu & 7;
    const bf16_t* P = (const bf16_t*)(p.ws + WS_P);
    const bf16_t* W1T = (const bf16_t*)(p.ws + (kv ? WS_W1TV : WS_W1TK)); const bf16_t* W2T = (const bf16_t*)(p.ws + (kv ? WS_W2TV : WS_W2TK));
    float* PART = (float*)lds;
    bf16_t* HS = (bf16_t*)(lds + 32768);
    const int fr = lane & 15, fq = lane >> 4;
    int n = 16 * nt + fr; if (n > 126) n = 126;
    const int colbase = (kv ? PC_VC : PC_KC) + g * 64;
    f32x4 acc[4];
#pragma unroll
    for (int i = 0; i < 4; ++i) acc[i] = (f32x4){0.f, 0.f, 0.f, 0.f};
#pragma unroll
    for (int ks = 0; ks < 8; ++ks) { const int kg = 256 * wave + 32 * ks + 8 * fq; const int t = kg >> 6, d = kg & 63;
        const bf16x8 a = *(const bf16x8*)(P + ((size_t)b * SEQ + 16 * n + t) * PW + colbase + d);
#pragma unroll
        for (int ntile = 0; ntile < 4; ++ntile) { const bf16x8 bb = *(const bf16x8*)(W1T + (size_t)(ntile * 16 + fr) * 2048 + kg); acc[ntile] = mfma16(a, bb, acc[ntile]); } }
    __syncthreads();
#pragma unroll
    for (int ntile = 0; ntile < 4; ++ntile)
#pragma unroll
        for (int i = 0; i < 4; ++i) PART[(wave * 16 + fq * 4 + i) * 64 + ntile * 16 + fr] = acc[ntile][i];
    __syncthreads();
    { const int rr = tid >> 5, c2 = (tid & 31) * 2; float v0 = ((const float*)(p.ws + WS_POSW1))[kv * 64 + c2], v1 = ((const float*)(p.ws + WS_POSW1))[kv * 64 + c2 + 1];
#pragma unroll
      for (int w = 0; w < 8; ++w) { v0 += PART[(w * 16 + rr) * 64 + c2]; v1 += PART[(w * 16 + rr) * 64 + c2 + 1]; }
      *(unsigned*)(HS + rr * KSTR + c2) = pk2(gelu_tanh(v0), gelu_tanh(v1)); }
    __syncthreads();
    if (wave < 4) { f32x4 a2 = (f32x4){0.f, 0.f, 0.f, 0.f};
#pragma unroll
        for (int s = 0; s < 2; ++s) { const bf16x8 a = *(const bf16x8*)(HS + fr * KSTR + 32 * s + 8 * fq); const bf16x8 bb = *(const bf16x8*)(W2T + (wave * 16 + fr) * 64 + 32 * s + 8 * fq); a2 = mfma16(a, bb, a2); }
        const int d = wave * 16 + fr;
#pragma unroll
        for (int i = 0; i < 4; ++i) { const int nn = 16 * nt + fq * 4 + i; const float val = nn <= 126 ? a2[i] : 0.f;
            if (kv == 0) ((bf16_t*)(p.ws + WS_KC))[((size_t)(b * 4 + g) * 128 + nn) * 64 + d] = f2bf(val);
            else ((bf16_t*)(p.ws + WS_VCT))[((size_t)(b * 4 + g) * 64 + d) * 128 + nn] = f2bf(val); } }
}

__device__ __forceinline__ void gla_unit(const Params& p, unsigned char* lds, int b, int h, int tid, int lane, int wave) {
    const bf16_t* P = (const bf16_t*)(p.ws + WS_P);
    float* BL = (float*)lds;
    bf16_t* QT = (bf16_t*)(lds + 32768);
    bf16_t* KH = (bf16_t*)(lds + 50176);
    bf16_t* KTt = (bf16_t*)(lds + 67584);
    bf16_t* VT = (bf16_t*)(lds + 86016);
    bf16_t* AT = (bf16_t*)(lds + 122880);
    float* SEG = (float*)(lds + 132096);
    float* EBL = (float*)(lds + 134144);
    float* LR = (float*)(lds + 122880);
    float* SSQ = (float*)(lds + 134656);
    const int l31 = lane & 31, hi = lane >> 5;
    const int gk = tid & 127, seg = tid >> 7;
    float* WG = (float*)(lds + 136704);
    const float bg = p.in[13][h * 128 + gk];
    __syncthreads();
    for (int i = tid; i < 2048; i += NTHREADS) WG[i] = p.in[12][(i >> 7) * 512 + h * 128 + (i & 127)];
    f32x16 S[4];
#pragma unroll
    for (int t = 0; t < 4; ++t)
#pragma unroll
        for (int i = 0; i < 16; ++i) S[t][i] = 0.f;
    const float qscale = 0.08838834764831845f;
    for (int c = 0; c < 32; ++c) {
        const size_t row0 = (size_t)b * SEQ + 64 * c;
        __syncthreads();
        for (int i = tid; i < 1024; i += NTHREADS) LR[i] = bf2f(P[(row0 + (i >> 4)) * PW + PC_LR + (i & 15)]);
        __syncthreads();
        { float run = 0.f;
          for (int ii = 0; ii < 16; ++ii) { const int i = 16 * seg + ii; float z = bg;
#pragma unroll
              for (int r = 0; r < 16; ++r) z += LR[i * 16 + r] * WG[r * 128 + gk];
              const float la = (fminf(z, 0.f) - __logf(1.0f + __expf(-fabsf(z)))) * 0.0625f;
              run += la; BL[i * 128 + gk] = run; }
          SEG[seg * 128 + gk] = run; }
        __syncthreads();
        {
            if (tid < 128) EBL[tid] = __expf(SEG[tid] + SEG[128 + tid] + SEG[256 + tid] + SEG[384 + tid]);
#pragma unroll 1
            for (int ps = 0; ps < 2; ++ps) { const int i = 32 * ps + (tid >> 4), k8 = (tid & 15) * 8; const int sg = i >> 4;
                const bf16x8 qv = *(const bf16x8*)(P + (row0 + i) * PW + PC_GQ + h * 128 + k8);
                const bf16x8 kv = *(const bf16x8*)(P + (row0 + i) * PW + PC_GK + h * 128 + k8);
                float qe[8], ke[8];
#pragma unroll
                for (int j = 0; j < 8; ++j) { const int k = k8 + j; float pre = 0.f, tot = 0.f;
#pragma unroll
                    for (int s2 = 0; s2 < 4; ++s2) { const float sv = SEG[s2 * 128 + k]; tot += sv; if (s2 < sg) pre += sv; }
                    const float bb = BL[i * 128 + k] + pre; const float kf = bf2f((unsigned short)kv[j]);
                    qe[j] = bf2f((unsigned short)qv[j]) * qscale * __expf(bb); ke[j] = kf * __expf(-bb);
                    KTt[k * KSTR + i] = f2bf(kf * __expf(tot - bb)); }
                u32x4 w; w.x = pk2(qe[0], qe[1]); w.y = pk2(qe[2], qe[3]); w.z = pk2(qe[4], qe[5]); w.w = pk2(qe[6], qe[7]); *(u32x4*)(QT + i * 136 + k8) = w;
                u32x4 w2; w2.x = pk2(ke[0], ke[1]); w2.y = pk2(ke[2], ke[3]); w2.z = pk2(ke[4], ke[5]); w2.w = pk2(ke[6], ke[7]); *(u32x4*)(KH + i * 136 + k8) = w2; }
#pragma unroll 1
            for (int ps = 0; ps < 4; ++ps) { const int i = 16 * ps + (tid >> 5), d8 = (tid & 31) * 8;
                const bf16x8 vv = *(const bf16x8*)(P + (row0 + i) * PW + PC_GV + h * 256 + d8);
#pragma unroll
                for (int j = 0; j < 8; ++j) VT[(d8 + j) * KSTR + i] = (bf16_t)vv[j]; }
        }
        __syncthreads();
        if (wave < 4) { const int jt = wave >> 1, itl = wave & 1;
            f32x16 cacc;
#pragma unroll
            for (int i = 0; i < 16; ++i) cacc[i] = 0.f;
            if (!(jt == 1 && itl == 0)) {
#pragma unroll
                for (int ks = 0; ks < 8; ++ks) { const bf16x8 a = *(const bf16x8*)(KH + (32 * jt + l31) * 136 + 16 * ks + 8 * hi); const bf16x8 bb = *(const bf16x8*)(QT + (32 * itl + l31) * 136 + 16 * ks + 8 * hi); cacc = mfma32(a, bb, cacc); } }
            const int i = 32 * itl + l31;
#pragma unroll
            for (int c4 = 0; c4 < 4; ++c4) { const int jb = 32 * jt + 8 * c4 + 4 * hi;
                const float a0 = (jb + 0 <= i) ? cacc[4 * c4 + 0] : 0.f, a1 = (jb + 1 <= i) ? cacc[4 * c4 + 1] : 0.f, a2 = (jb + 2 <= i) ? cacc[4 * c4 + 2] : 0.f, a3 = (jb + 3 <= i) ? cacc[4 * c4 + 3] : 0.f;
                u32x2 w; w.x = pk2(a0, a1); w.y = pk2(a2, a3); *(u32x2*)(AT + i * KSTR + jb) = w; } }
        __syncthreads();
        f32x16 oT[2];
#pragma unroll
        for (int i = 0; i < 16; ++i) { oT[0][i] = 0.f; oT[1][i] = 0.f; }
#pragma unroll
        for (int dkt = 0; dkt < 4; ++dkt) {
#pragma unroll
            for (int s = 0; s < 2; ++s) {
                u32x4 sw; sw.x = pk2(S[dkt][8 * s + 0], S[dkt][8 * s + 1]); sw.y = pk2(S[dkt][8 * s + 2], S[dkt][8 * s + 3]); sw.z = pk2(S[dkt][8 * s + 4], S[dkt][8 * s + 5]); sw.w = pk2(S[dkt][8 * s + 6], S[dkt][8 * s + 7]);
                const bf16x8 sa = __builtin_bit_cast(bf16x8, sw);
                const bf16_t* qb0 = QT + l31 * 136 + 32 * dkt + 16 * s + 4 * hi; const bf16_t* qb1 = qb0 + 32 * 136;
                oT[0] = mfma32(sa, cat4(*(const s16x4*)qb0, *(const s16x4*)(qb0 + 8)), oT[0]);
                oT[1] = mfma32(sa, cat4(*(const s16x4*)qb1, *(const s16x4*)(qb1 + 8)), oT[1]); }
            __builtin_amdgcn_sched_barrier(0); }
#pragma unroll
        for (int s4 = 0; s4 < 4; ++s4) { const bf16x8 a = *(const bf16x8*)(VT + (32 * wave + l31) * KSTR + 16 * s4 + 8 * hi);
            oT[0] = mfma32(a, *(const bf16x8*)(AT + l31 * KSTR + 16 * s4 + 8 * hi), oT[0]);
            oT[1] = mfma32(a, *(const bf16x8*)(AT + (32 + l31) * KSTR + 16 * s4 + 8 * hi), oT[1]); }
        __builtin_amdgcn_sched_barrier(0);
#pragma unroll
        for (int dkt = 0; dkt < 4; ++dkt) {
#pragma unroll
            for (int i = 0; i < 16; ++i) S[dkt][i] *= EBL[32 * dkt + (i & 3) + 8 * (i >> 2) + 4 * hi];
#pragma unroll
            for (int s4 = 0; s4 < 4; ++s4) { const bf16x8 a = *(const bf16x8*)(KTt + (32 * dkt + l31) * KSTR + 16 * s4 + 8 * hi); const bf16x8 bb = *(const bf16x8*)(VT + (32 * wave + l31) * KSTR + 16 * s4 + 8 * hi); S[dkt] = mfma32(a, bb, S[dkt]); }
            __builtin_amdgcn_sched_barrier(0); }
        { float q0 = 0.f, q1 = 0.f;
#pragma unroll
          for (int i = 0; i < 16; ++i) { q0 += oT[0][i] * oT[0][i]; q1 += oT[1][i] * oT[1][i]; }
          q0 += __shfl_xor(q0, 32); q1 += __shfl_xor(q1, 32);
          if (hi == 0) { SSQ[wave * 64 + l31] = q0; SSQ[wave * 64 + 32 + l31] = q1; } }
        __syncthreads();
#pragma unroll
        for (int itl = 0; itl < 2; ++itl) { const int i = 32 * itl + l31; float tot = 0.f;
#pragma unroll
            for (int w = 0; w < 8; ++w) tot += SSQ[w * 64 + i];
            const float rstd = rsqrtf(tot * (1.0f / 256.0f) + EPS);
            const bf16_t* og = P + (row0 + i) * PW + PC_GO + h * 256 + 32 * wave;
            bf16_t* mx = (bf16_t*)(p.ws + WS_H) + (row0 + i) * DM + 1024 + h * 256 + 32 * wave;
#pragma unroll
            for (int c4 = 0; c4 < 4; ++c4) { const int d = 8 * c4 + 4 * hi; const u32x2 gq = *(const u32x2*)(og + d);
                const f32x4 nw = *(const f32x4*)(p.in[14] + 32 * wave + d);
                const float g0 = __uint_as_float(gq.x << 16), g1 = __uint_as_float(gq.x & 0xffff0000u), g2 = __uint_as_float(gq.y << 16), g3 = __uint_as_float(gq.y & 0xffff0000u);
                const float v0 = oT[itl][4 * c4] * rstd * nw.x * pg8::silu_f(g0), v1 = oT[itl][4 * c4 + 1] * rstd * nw.y * pg8::silu_f(g1), v2 = oT[itl][4 * c4 + 2] * rstd * nw.z * pg8::silu_f(g2), v3 = oT[itl][4 * c4 + 3] * rstd * nw.w * pg8::silu_f(g3);
                u32x2 o; o.x = pk2(v0, v1); o.y = pk2(v2, v3); *(u32x2*)(mx + d) = o; }
            __builtin_amdgcn_sched_barrier(0); }
    }
}

__device__ __forceinline__ void p6_norm2_route(const Params& p, unsigned char* lds, int tid, int lane, int wave) {
    unsigned char* ws = p.ws; const float* X2 = p.out; bf16_t* H2 = (bf16_t*)(ws + WS_H);
    const bf16_t* WRH = (const bf16_t*)(ws + WS_WRH); const bf16_t* WRL = (const bf16_t*)(ws + WS_WRL);
    float* LG = (float*)(lds + wave * 4096);
    const int fr = lane & 15, fq = lane >> 4;
    unsigned* ctl = (unsigned*)(ws + WS_CTL);
    for (int task = wave * gridDim.x + blockIdx.x; task < 512; task += NWAVES * gridDim.x) {
        const int row0 = 16 * task, b = row0 >> 11;
        float myrstd = 0.f;
        for (int rr = 0; rr < 16; ++rr) { const f32x4* xr = (const f32x4*)(X2 + (size_t)(row0 + rr) * DM) + lane; float s = 0.f;
#pragma unroll
            for (int j = 0; j < 8; ++j) { const f32x4 v = xr[64 * j]; s += (v.x * v.x + v.y * v.y) + (v.z * v.z + v.w * v.w); }
            const float tot = wave_sum(s); if (fr == rr) myrstd = rsqrtf(tot * (1.0f / DM) + EPS); }
        const float* xrow = X2 + (size_t)(row0 + fr) * DM; const float* a2 = (const float*)(ws + WS_A2G) + b * 2048; const float* s2 = (const float*)(ws + WS_SH2G) + b * 2048;
        bf16_t* hrow = H2 + (size_t)(row0 + fr) * DM;
        f32x4 acc[3];
#pragma unroll
        for (int i = 0; i < 3; ++i) acc[i] = (f32x4){0.f, 0.f, 0.f, 0.f};
#pragma unroll 2
        for (int ks = 0; ks < 64; ++ks) { const int k0 = 32 * ks + 8 * fq;
            const f32x4 x0 = *(const f32x4*)(xrow + k0), x1 = *(const f32x4*)(xrow + k0 + 4), aa0 = *(const f32x4*)(a2 + k0), aa1 = *(const f32x4*)(a2 + k0 + 4), ss0 = *(const f32x4*)(s2 + k0), ss1 = *(const f32x4*)(s2 + k0 + 4);
            const f32x4 h0 = x0 * myrstd * aa0 + ss0, h1 = x1 * myrstd * aa1 + ss1;
            u32x4 hw; hw.x = pk2(h0.x, h0.y); hw.y = pk2(h0.z, h0.w); hw.z = pk2(h1.x, h1.y); hw.w = pk2(h1.z, h1.w);
            *(u32x4*)(hrow + k0) = hw;
            u32x4 lw; lw.x = pk2(h0.x - __uint_as_float(hw.x << 16), h0.y - __uint_as_float(hw.x & 0xffff0000u)); lw.y = pk2(h0.z - __uint_as_float(hw.y << 16), h0.w - __uint_as_float(hw.y & 0xffff0000u));
            lw.z = pk2(h1.x - __uint_as_float(hw.z << 16), h1.y - __uint_as_float(hw.z & 0xffff0000u)); lw.w = pk2(h1.z - __uint_as_float(hw.w << 16), h1.w - __uint_as_float(hw.w & 0xffff0000u));
            const bf16x8 hf = __builtin_bit_cast(bf16x8, hw), lf = __builtin_bit_cast(bf16x8, lw);
#pragma unroll
            for (int nt = 0; nt < 3; ++nt) { const bf16x8 bh = *(const bf16x8*)(WRH + (size_t)(nt * 16 + fr) * 2048 + k0), bl = *(const bf16x8*)(WRL + (size_t)(nt * 16 + fr) * 2048 + k0);
                acc[nt] = mfma16(hf, bh, acc[nt]); acc[nt] = mfma16(hf, bl, acc[nt]); acc[nt] = mfma16(lf, bh, acc[nt]); } }
#pragma unroll
        for (int nt = 0; nt < 3; ++nt)
#pragma unroll
            for (int i = 0; i < 4; ++i) LG[(fq * 4 + i) * 49 + nt * 16 + fr] = acc[nt][i];
        asm volatile("s_waitcnt lgkmcnt(0)" ::: "memory");
        if (lane < 16) { const float* lg = LG + lane * 49; const int tok = row0 + lane;
            float gl[4]; int grp = 0; float gmax = -1e30f;
#pragma unroll
            for (int j = 0; j < 4; ++j) { gl[j] = lg[32 + j] + p.in[18][j]; if (gl[j] > gmax) { gmax = gl[j]; grp = j; } }
            float gs = 0.f;
#pragma unroll
            for (int j = 0; j < 4; ++j) gs += __expf(gl[j] - gmax);
            const float grp_p = 1.0f / gs;
            float v1 = -1e30f, v2 = -1e30f; int i1 = 0, i2 = 0;
            for (int j = 0; j < 8; ++j) { const float v = lg[grp * 8 + j] + p.in[20][grp * 8 + j];
                if (v > v1) { v2 = v1; i2 = i1; v1 = v; i1 = j; } else if (v > v2) { v2 = v; i2 = j; } }
            const float e2 = __expf(v2 - v1); const float w1 = grp_p / (1.0f + e2), w2 = grp_p * e2 / (1.0f + e2);
            const int ea = grp * 8 + i1, eb = grp * 8 + i2;
            const int pa = (int)atomicAdd(ctl + CW_ECNT + 16 * ea, 1u), pb = (int)atomicAdd(ctl + CW_ECNT + 16 * eb, 1u);
            int* te = (int*)(ws + WS_TOKE); float* tw = (float*)(ws + WS_TOKW); int* tp = (int*)(ws + WS_TOKP);
            te[2 * tok] = ea; te[2 * tok + 1] = eb; tw[2 * tok] = w1; tw[2 * tok + 1] = w2; tp[2 * tok] = pa; tp[2 * tok + 1] = pb; }
        asm volatile("s_waitcnt lgkmcnt(0)" ::: "memory");
    }
}

__device__ __forceinline__ void p7_dispatch(const Params& p, unsigned char* lds, int tid, int lane, int wave) {
    unsigned char* ws = p.ws; unsigned* ctl = (unsigned*)(ws + WS_CTL);
    int* PST = (int*)lds;
    volatile int* PSTv = (volatile int*)PST;
    if (tid < 32) PSTv[64 + tid] = (int)__hip_atomic_load(ctl + CW_ECNT + 16 * tid, __ATOMIC_RELAXED, __HIP_MEMORY_SCOPE_AGENT);
    __syncthreads();
    if (tid == 0) { int acc = 0;
#pragma unroll 1
        for (int e = 0; e < 32; ++e) { const int c = PSTv[64 + e]; PSTv[e] = acc; acc += (c + 255) & ~255; } PSTv[32] = acc; }
    __syncthreads();
    int* slot_tok = (int*)(ws + WS_SLOTT); float* slot_w = (float*)(ws + WS_SLOTW); int* rbe = (int*)(ws + WS_RBE);
    if (blockIdx.x == 0) {
        const int nrb = PST[32] >> 8;
        if (tid == 0) rbe[128] = nrb;
        for (int rb = tid; rb < nrb; rb += NTHREADS) { int e = 0;
#pragma unroll 1
            for (int q = 0; q < 32; ++q) if (PSTv[q] <= rb * 256 && rb * 256 < PSTv[q + 1]) e = q;
            rbe[rb] = e; }
#pragma unroll 1
        for (int e = 0; e < 32; ++e) { const int s0 = PSTv[e] + PSTv[64 + e], s1 = PSTv[e + 1]; for (int s = s0 + tid; s < s1; s += NTHREADS) slot_tok[s] = -1; }
    }
    const int gw = blockIdx.x * NWAVES + wave, NGW = gridDim.x * NWAVES;
    const int* te = (const int*)(ws + WS_TOKE); const float* tw = (const float*)(ws + WS_TOKW); const int* tp = (const int*)(ws + WS_TOKP);
    const bf16_t* H2 = (const bf16_t*)(ws + WS_H); bf16_t* XS = (bf16_t*)(ws + WS_P);
    for (int pair = gw; pair < 16384; pair += NGW) { const int tok = pair >> 1; const int e = te[pair], pos = tp[pair]; const int slot = PST[e] + pos;
        const u32x4* src = (const u32x4*)(H2 + (size_t)tok * DM) + lane; u32x4* dst = (u32x4*)(XS + (size_t)slot * DM) + lane;
#pragma unroll
        for (int j = 0; j < 4; ++j) dst[64 * j] = src[64 * j];
        if (lane == 0) { slot_tok[slot] = pair; slot_w[slot] = tw[pair]; } }
}

__device__ __forceinline__ void p10_final(const Params& p, int tid, int lane, int wave) {
    unsigned char* ws = p.ws; const bf16_t* Y = (const bf16_t*)(ws + WS_P); const float* MODF = (const float*)(ws + WS_MODF);
    const int gw = blockIdx.x * NWAVES + wave, NGW = gridDim.x * NWAVES;
    for (int row = gw; row < NTOK; row += NGW) { const int b = row >> 11;
        f32x4* xr = (f32x4*)(p.out + (size_t)row * DM) + lane; const u32x2* y0 = (const u32x2*)(Y + (size_t)(2 * row) * DM) + lane; const u32x2* y1 = (const u32x2*)(Y + (size_t)(2 * row + 1) * DM) + lane;
        const f32x4* g2 = (const f32x4*)(MODF + (size_t)b * 12288 + 10240) + lane; const f32x4* nf = (const f32x4*)p.in[24] + lane;
        f32x4 v[8]; float s = 0.f;
#pragma unroll
        for (int j = 0; j < 8; ++j) { const f32x4 x = xr[64 * j]; const u32x2 a = y0[64 * j], c = y1[64 * j]; const f32x4 gg = g2[64 * j];
            f32x4 ys; ys.x = __uint_as_float(a.x << 16) + __uint_as_float(c.x << 16); ys.y = __uint_as_float(a.x & 0xffff0000u) + __uint_as_float(c.x & 0xffff0000u);
            ys.z = __uint_as_float(a.y << 16) + __uint_as_float(c.y << 16); ys.w = __uint_as_float(a.y & 0xffff0000u) + __uint_as_float(c.y & 0xffff0000u);
            v[j] = x + gg * ys; s += (v[j].x * v[j].x + v[j].y * v[j].y) + (v[j].z * v[j].z + v[j].w * v[j].w); }
        const float rstd = rsqrtf(wave_sum(s) * (1.0f / DM) + EPS);
#pragma unroll
        for (int j = 0; j < 8; ++j) xr[64 * j] = v[j] * rstd * nf[64 * j]; }
}

__global__ void __launch_bounds__(NTHREADS, 2) fwd_megakernel(Params p) {
    extern __shared__ __attribute__((aligned(16))) unsigned char lds[];
    cg::grid_group grid = cg::this_grid();
    const int tid = threadIdx.x, lane = tid & 63, wave = __builtin_amdgcn_readfirstlane(tid >> 6);
    unsigned char* ws = p.ws; unsigned* ctl = (unsigned*)(ws + WS_CTL);
    volatile int* qslot = (volatile int*)(lds + LDS_BYTES - 64);
    LAS unsigned char* lds3 = (LAS unsigned char*)lds;

#ifndef SKIP_P0
    p0_prologue(p, lds, tid, lane, wave);
#endif
    grid.sync();
#ifndef SKIP_P1
    p1_norm1(p, lds, tid, lane, wave);
#endif
    grid.sync();
#ifndef SKIP_G2
    { pg8::Gemm g{(const bf16_t*)(ws + WS_H), (const bf16_t*)(ws + WS_WIN), NTOK, PW, DM}; pg8::StaticOrder S; S.init(NTOK, PW, (int)gridDim.x, (int)blockIdx.x);
      pg8::EpiBf16<0> E{(bf16_t*)(ws + WS_P), PW, nullptr, 0, 0, 1.f};
      pg8::gemm_phase<pg8::EpiBf16<0>, pg8::StaticOrder, true, true>(lds3, g, S, E); }
#endif
    grid.sync();
#ifndef SKIP_GLA
    for (int gi = blockIdx.x; gi < 16; gi += gridDim.x) gla_unit(p, lds, gi >> 2, gi & 3, tid, lane, wave);
#endif
    for (;;) { const int it = fetch_item(ctl + CW_Q3, qslot, tid); if (it >= 256 + 512) break;
#ifndef SKIP_CMP
        if (it < 256) nsa_compress_unit(p, lds, it, tid, lane, wave); else
#endif
#ifndef SKIP_WIN
        { const int u = it - 256; const int qblk = 31 - (u >> 4), bg = u & 15; nsa_window_unit(p, lds, bg >> 2, bg & 3, qblk, tid, lane, wave); }
#endif
        ; }
    grid.sync();
    for (;;) { const int it = fetch_item(ctl + CW_Q4, qslot, tid); if (it >= 512) break;
#ifndef SKIP_SEL
        const int qblk = 31 - (it >> 4), bg = it & 15; nsa_cmp_sel_unit(p, lds, bg >> 2, bg & 3, qblk, tid, lane, wave);
#endif
        }
    grid.sync();
#ifndef SKIP_G5
    { pg8::Gemm g{(const bf16_t*)(ws + WS_H), (const bf16_t*)(ws + WS_WOUT), NTOK, DM, DM}; pg8::StaticOrder S; S.init(NTOK, DM, (int)gridDim.x, (int)blockIdx.x);
      pg8::EpiResid E{p.in[0], p.out, (const float*)(ws + WS_MODF) + 4096};
      pg8::gemm_phase<pg8::EpiResid, pg8::StaticOrder, true, true>(lds3, g, S, E); }
#endif
    grid.sync();
#ifndef SKIP_P6
    p6_norm2_route(p, lds, tid, lane, wave);
#endif
    grid.sync();
#ifndef SKIP_P7
    p7_dispatch(p, lds, tid, lane, wave);
#endif
    grid.sync();
    const int nrb = __hip_atomic_load((const int*)(ws + WS_RBE) + 128, __ATOMIC_RELAXED, __HIP_MEMORY_SCOPE_AGENT);
#ifndef SKIP_G8
    { pg8::Gemm g{(const bf16_t*)(ws + WS_P), (const bf16_t*)(ws + WS_WGU), CAP, 32 * 1024, DM}; pg8::GroupedOrder S{(const int*)(ws + WS_RBE), nrb * 4, 4, (int)gridDim.x, (int)blockIdx.x};
      pg8::EpiSwiGLU E{(bf16_t*)(ws + WS_HMID)};
      pg8::gemm_phase<pg8::EpiSwiGLU, pg8::GroupedOrder, true, true>(lds3, g, S, E); }
#endif
    grid.sync();
#ifndef SKIP_G9
    { pg8::Gemm g{(const bf16_t*)(ws + WS_HMID), (const bf16_t*)(ws + WS_WD), CAP, 32 * 2048, 512}; pg8::GroupedOrder S{(const int*)(ws + WS_RBE), nrb * 8, 8, (int)gridDim.x, (int)blockIdx.x};
      pg8::EpiDown E{(bf16_t*)(ws + WS_P), (const int*)(ws + WS_SLOTT), (const float*)(ws + WS_SLOTW)};
      pg8::gemm_phase<pg8::EpiDown, pg8::GroupedOrder, true, true>(lds3, g, S, E); }
#endif
    grid.sync();
#ifndef SKIP_P10
    p10_final(p, tid, lane, wave);
#endif
}

extern "C" void kernel_launch(void* const* d_in, const int* in_sizes, int n_in, void* d_out, int out_size, void* d_ws, size_t ws_size, hipStream_t stream) {
    static int grid_blocks = 0;
    if (!grid_blocks) {
        int dev = 0, cus = 0, per_cu = 0;
        (void)hipGetDevice(&dev);
        (void)hipDeviceGetAttribute(&cus, hipDeviceAttributeMultiprocessorCount, dev);
        (void)hipFuncSetAttribute((const void*)fwd_megakernel, hipFuncAttributeMaxDynamicSharedMemorySize, LDS_BYTES);
        (void)hipOccupancyMaxActiveBlocksPerMultiprocessor(&per_cu, (const void*)fwd_megakernel, NTHREADS, LDS_BYTES);
        if (per_cu < 1) fprintf(stderr, "kernel_launch: occupancy query reports %d blocks/CU\n", per_cu);
        grid_blocks = cus;
        if (ws_size < WS_END || n_in != 25) { fprintf(stderr, "kernel_launch: ws %zu < %zu or n_in %d != 25\n", ws_size, (size_t)WS_END, n_in); }
    }
    (void)hipMemsetAsync((char*)d_ws + WS_CTL, 0, CTL_ZERO_BYTES, stream);
    Params p{};
    for (int i = 0; i < 25; ++i) p.in[i] = (const float*)d_in[i];
    p.out = (float*)d_out; p.ws = (unsigned char*)d_ws;
    void* args[] = {&p};
    hipError_t e = hipLaunchCooperativeKernel((void*)fwd_megakernel, dim3(grid_blocks), dim3(NTHREADS), args, LDS_BYTES, stream);
    if (e != hipSuccess) fprintf(stderr, "cooperative launch failed: %s (grid %d)\n", hipGetErrorString(e), grid_blocks);
}
```

```cpp
#include <hip/hip_runtime.h>
#include <hip/hip_cooperative_groups.h>
#include <cstdio>
#include <cstdint>
namespace cg = cooperative_groups;
namespace pg8 {
#define PG8_LAS __attribute__((address_space(3)))
typedef unsigned short bf16_t;
typedef short bf16x8 __attribute__((ext_vector_type(8)));
typedef float f32x4 __attribute__((ext_vector_type(4)));
typedef unsigned u32x4 __attribute__((ext_vector_type(4)));
constexpr int BM = 256, BK = 64, HALF = 128, HTB = HALF * BK * 2  , STAGE_BYTES = 8 * HTB, NXCD = 8, WGM = 8;

__host__ __device__ __forceinline__ int lds_byte(int r, int c) { const int st = (r >> 4) * 2 + (c >> 5), rr = r & 15, cc = c & 31, ob = rr * 64 + cc * 2; return st * 1024 + (ob ^ (((ob >> 9) & 1) << 5)); }
__host__ __device__ __forceinline__ void stage_rc(int b, int& R, int& C) { const int st = b / 1024, sb = b % 1024, swz = sb ^ (((sb >> 9) & 1) << 5); R = (st >> 1) * 16 + swz / 64; C = (st & 1) * 32 + (swz % 64) / 2; }
__host__ __device__ __forceinline__ int perm32(int rho) { const int n = rho >> 4, i = rho & 15; return 8 * (i >> 2) + 4 * n + (i & 3); }

struct Unit { int pm, pn; };
struct Gemm { const bf16_t* A; const bf16_t* Bt; int M, N, K; };

struct StaticOrder {
    int nM, nN, nwg, G, c;
    __host__ __device__ void init(int M, int N, int G_, int c_) { nM = M / BM; nN = N / BM; nwg = nM * nN; G = G_; c = c_; }
    __host__ __device__ bool next(int i, Unit& u) const {
        const long L = (long)i * G + c; if (L >= nwg) return false;
        int wgid = (int)L; { const int q = nwg / NXCD, r = nwg % NXCD, xcd = wgid % NXCD, off = wgid / NXCD; wgid = (xcd < r ? xcd * (q + 1) : r * (q + 1) + (xcd - r) * q) + off; }
        const int nig = WGM * nN, gid = wgid / nig, fm = gid * WGM, gsz = (nM - fm) < WGM ? (nM - fm) : WGM;
        u.pm = fm + ((wgid % nig) % gsz); u.pn = (wgid % nig) / gsz; return true;
    }
    __device__ __forceinline__ void a_ready(const Unit&) const {}
    __device__ __forceinline__ void done(const Unit&) const {}
};

__device__ __forceinline__ unsigned cvt_pk_bf16(float lo, float hi) { unsigned r; asm volatile("v_cvt_pk_bf16_f32 %0, %1, %2" : "=v"(r) : "v"(lo), "v"(hi)); return r; }
typedef float f32x2 __attribute__((ext_vector_type(2)));
__device__ __forceinline__ f32x2 gelu_pk(f32x2 v) {
    const f32x2 av = __builtin_elementwise_abs(v), d = av * 0.2316418882f + 1.0f;
    f32x2 t; t.x = __builtin_amdgcn_rcpf(d.x); t.y = __builtin_amdgcn_rcpf(d.y);
    f32x2 q = t * 0.5307027145f + (-0.7265760135f); q = q * t + 0.7107068705f; q = q * t + (-0.142248368f); q = q * t + 0.127414796f; q = q * t;
    const f32x2 s = (v * v) * (-0.72134752044f);
    f32x2 e; e.x = __builtin_amdgcn_exp2f(s.x); e.y = __builtin_amdgcn_exp2f(s.y);
    const f32x2 m = v * (q * e), r = v - m;
    f32x2 o; o.x = v.x < 0.f ? m.x : r.x; o.y = v.y < 0.f ? m.y : r.y; return o;
}

template <int ACT  > struct EpiBf16 {
    static constexpr bool PERM = true, AFTER_DRAIN = false; static_assert(ACT == 0 || ACT == 1, "EpiBf16: ACT is 0 (none) or 1 (gelu_pk)");
    bf16_t* O; int ldc; const float* bias; int split_cols; size_t split_stride; float scale0;
    __device__ __forceinline__ void operator()(const f32x4 (&acc)[2][2][4][2], const Unit& u, int wr, int wc, int fr, int fq) const {
        const int row0 = u.pm * BM + wr * 64 + fr; int colt = u.pn * BM; bf16_t* base = O;
        float sc = 1.f; if (split_cols) { const int t = colt / split_cols; base += (size_t)t * split_stride; colt -= t * split_cols; if (t == 0) sc = scale0; }
        const int col0 = colt + wc * 32 + 8 * fq, bcol0 = u.pn * BM + wc * 32 + 8 * fq;
        f32x4 bv[2][2];
#pragma unroll
        for (int bj = 0; bj < 2; ++bj)
#pragma unroll
            for (int n = 0; n < 2; ++n) bv[bj][n] = bias ? *(const f32x4*)(bias + bcol0 + bj * HALF + 4 * n) : (f32x4){0.f, 0.f, 0.f, 0.f};
#pragma unroll
        for (int ai = 0; ai < 2; ++ai)
#pragma unroll
            for (int m = 0; m < 4; ++m) { bf16_t* rowp = base + (size_t)(row0 + ai * HALF + m * 16) * ldc + col0;
#pragma unroll
                for (int bj = 0; bj < 2; ++bj) { f32x4 v0 = acc[ai][bj][m][0] + bv[bj][0], v1 = acc[ai][bj][m][1] + bv[bj][1];
                    if (ACT == 1) { f32x2 a = gelu_pk((f32x2){v0[0], v0[1]}), b = gelu_pk((f32x2){v0[2], v0[3]}), c = gelu_pk((f32x2){v1[0], v1[1]}), d = gelu_pk((f32x2){v1[2], v1[3]});
                        v0 = (f32x4){a.x, a.y, b.x, b.y}; v1 = (f32x4){c.x, c.y, d.x, d.y}; }
                    v0 = v0 * sc; v1 = v1 * sc; u32x4 w; w.x = cvt_pk_bf16(v0[0], v0[1]); w.y = cvt_pk_bf16(v0[2], v0[3]); w.z = cvt_pk_bf16(v1[0], v1[1]); w.w = cvt_pk_bf16(v1[2], v1[3]);
                    *(u32x4*)(rowp + bj * HALF) = w; } }
    }
};
template <class Epi, class Sched, bool ALIGN_EPI = false, bool SP2 = false>
__device__ __forceinline__ void gemm_phase(PG8_LAS unsigned char* lds, const Gemm g, const Sched& S, const Epi& E) {
    const int tid = threadIdx.x, wid = __builtin_amdgcn_readfirstlane(tid >> 6), lane = tid & 63, wr = wid >> 2, wc = wid & 3, fr = lane & 15, fq = lane >> 4;
    const int K = g.K, nt = K / BK;
    unsigned voffA[2], voffB[2];
#pragma unroll
    for (int i = 0; i < 2; ++i) { int R, C; stage_rc(tid * 16 + i * 8192, R, C); const int Rb = Epi::PERM ? ((R & ~31) + perm32(R & 31)) : R;
        voffA[i] = (unsigned)(R * K + C) * 2u; voffB[i] = (unsigned)(Rb * K + C) * 2u; }
    const size_t kstep = (size_t)(BK * 2);
    const size_t hstep = (size_t)HALF * K * 2;
    const size_t tstep = 2 * hstep;
    const unsigned ldsw = (unsigned)wid * 1024u;
    const int aoff = lds_byte(wr * 64 + fr, fq * 8), boff = lds_byte(wc * 32 + fr, fq * 8);
#define PG8_SA(b, h) (((b) * 2 + (h)) * HTB)
#define PG8_SB(b, h) ((4 + (b) * 2 + (h)) * HTB)
#define PG8_STAGE(bufoff, gbase, voff) do { _Pragma("unroll") for (int _i = 0; _i < 2; ++_i) \
        __builtin_amdgcn_global_load_lds((const unsigned*)((const char*)(gbase) + (voff)[_i]), (PG8_LAS unsigned*)(lds + (bufoff) + ldsw + _i * 8192), 16, 0, 0); } while (0)
#define PG8_LDA(dst, b, h) do { _Pragma("unroll") for (int m = 0; m < 4; ++m) _Pragma("unroll") for (int k = 0; k < 2; ++k) dst[m][k] = *(const PG8_LAS bf16x8*)(lds + PG8_SA(b, h) + aoff + m * 2048 + k * 1024); } while (0)
#define PG8_LDB(dst, b, h) do { _Pragma("unroll") for (int n = 0; n < 2; ++n) _Pragma("unroll") for (int k = 0; k < 2; ++k) dst[n][k] = *(const PG8_LAS bf16x8*)(lds + PG8_SB(b, h) + boff + n * 2048 + k * 1024); } while (0)
#define PG8_MMA(ai, bj, At, Bt) do { __builtin_amdgcn_s_setprio(1); _Pragma("unroll") for (int m = 0; m < 4; ++m) _Pragma("unroll") for (int n = 0; n < 2; ++n) _Pragma("unroll") for (int k = 0; k < 2; ++k) \
        acc[ai][bj][m][n] = __builtin_amdgcn_mfma_f32_16x16x32_bf16(Bt[n][k], At[m][k], acc[ai][bj][m][n], 0, 0, 0); __builtin_amdgcn_s_setprio(0); } while (0)
#define PG8_WAIT_V(n) asm volatile("s_waitcnt vmcnt(" #n ")" ::: "memory")
#define PG8_WAIT_L(n) asm volatile("s_waitcnt lgkmcnt(" #n ")" ::: "memory")
#define PG8_BAR __builtin_amdgcn_s_barrier()
#define PG8_SCHED __builtin_amdgcn_sched_barrier(0)
    Unit cur, nxt; int ui = 0;
    if (!S.next(0, cur)) return;
    f32x4 acc[2][2][4][2];
#pragma unroll
    for (int a = 0; a < 2; ++a)
#pragma unroll
        for (int b = 0; b < 2; ++b)
#pragma unroll
            for (int m = 0; m < 4; ++m)
#pragma unroll
                for (int n = 0; n < 2; ++n) acc[a][b][m][n] = (f32x4){0.f, 0.f, 0.f, 0.f};
    bf16x8 At[4][2], B0[2][2], B1[2][2];
    const char* cA = (const char*)g.A + (size_t)cur.pm * tstep; const char* cB = (const char*)g.Bt + (size_t)cur.pn * tstep;
    S.a_ready(cur);
    if constexpr (SP2) {
        PG8_STAGE(PG8_SB(0, 0), cB, voffB); PG8_STAGE(PG8_SB(0, 1), cB + hstep, voffB); PG8_STAGE(PG8_SA(0, 0), cA, voffA); PG8_STAGE(PG8_SA(0, 1), cA + hstep, voffA);
        if (wr == 1) PG8_BAR;
        PG8_WAIT_V(2); PG8_BAR;
        PG8_STAGE(PG8_SB(1, 0), cB + kstep, voffB); PG8_STAGE(PG8_SA(1, 0), cA + kstep, voffA); PG8_STAGE(PG8_SB(1, 1), cB + hstep + kstep, voffB);
        PG8_WAIT_V(6); PG8_BAR;
    } else {
        PG8_STAGE(PG8_SB(0, 0), cB, voffB); PG8_STAGE(PG8_SA(0, 0), cA, voffA); PG8_STAGE(PG8_SB(0, 1), cB + hstep, voffB); PG8_STAGE(PG8_SA(0, 1), cA + hstep, voffA);
        if (wr == 1) PG8_BAR;
        PG8_WAIT_V(4); PG8_BAR;
        PG8_STAGE(PG8_SB(1, 0), cB + kstep, voffB); PG8_STAGE(PG8_SA(1, 0), cA + kstep, voffA); PG8_STAGE(PG8_SB(1, 1), cB + hstep + kstep, voffB);
        PG8_WAIT_V(6); PG8_BAR;
    }
    for (;;) {
        const bool has_next = S.next(ui + 1, nxt);
        const char* nA = has_next ? (const char*)g.A + (size_t)nxt.pm * tstep : cA; const char* nB = has_next ? (const char*)g.Bt + (size_t)nxt.pn * tstep : cB;
        for (int t = 0; t < nt; t += 2) {
            const bool last = (t == nt - 2);
            const char* a1 = cA + (size_t)(t + 1) * kstep;
            const char* a2 = last ? nA : cA + (size_t)(t + 2) * kstep; const char* b2 = last ? nB : cB + (size_t)(t + 2) * kstep;
            const char* a3 = a2 + kstep; const char* b3 = b2 + kstep;
            if (last && has_next) S.a_ready(nxt);
            if constexpr (SP2) {
            PG8_LDB(B0, 0, 0); PG8_LDB(B1, 0, 1); PG8_SCHED; PG8_LDA(At, 0, 0); PG8_STAGE(PG8_SA(1, 1), a1 + hstep, voffA);
            PG8_WAIT_V(8); PG8_WAIT_L(0); PG8_BAR; PG8_MMA(0, 0, At, B0); PG8_MMA(0, 1, At, B1); PG8_BAR; PG8_SCHED;
            PG8_LDA(At, 0, 1); PG8_STAGE(PG8_SB(0, 0), b2, voffB); PG8_STAGE(PG8_SB(0, 1), b2 + hstep, voffB); PG8_STAGE(PG8_SA(0, 0), a2, voffA);
            PG8_WAIT_V(8); PG8_WAIT_L(0); PG8_BAR; PG8_MMA(1, 0, At, B0); PG8_MMA(1, 1, At, B1); PG8_BAR; PG8_SCHED;
            PG8_LDB(B0, 1, 0); PG8_LDB(B1, 1, 1); PG8_SCHED; PG8_LDA(At, 1, 0); PG8_STAGE(PG8_SA(0, 1), a2 + hstep, voffA);
            PG8_WAIT_V(8); PG8_WAIT_L(0); PG8_BAR; PG8_MMA(0, 0, At, B0); PG8_MMA(0, 1, At, B1); PG8_BAR; PG8_SCHED;
            PG8_LDA(At, 1, 1); PG8_STAGE(PG8_SB(1, 0), b3, voffB); PG8_STAGE(PG8_SB(1, 1), b3 + hstep, voffB); PG8_STAGE(PG8_SA(1, 0), a3, voffA);
            PG8_WAIT_V(8); PG8_WAIT_L(0); PG8_BAR; PG8_MMA(1, 0, At, B0); PG8_MMA(1, 1, At, B1); PG8_BAR; PG8_SCHED;
            } else {
            PG8_LDB(B0, 0, 0); PG8_SCHED; PG8_LDA(At, 0, 0); PG8_STAGE(PG8_SA(1, 1), a1 + hstep, voffA);
            PG8_WAIT_L(8); PG8_BAR; PG8_WAIT_L(0); PG8_MMA(0, 0, At, B0); PG8_BAR; PG8_SCHED;
            PG8_LDB(B1, 0, 1); PG8_STAGE(PG8_SB(0, 0), b2, voffB);
            PG8_BAR; PG8_WAIT_L(0); PG8_MMA(0, 1, At, B1); PG8_BAR;
            PG8_LDA(At, 0, 1); PG8_STAGE(PG8_SA(0, 0), a2, voffA);
            PG8_BAR; PG8_WAIT_L(0); PG8_MMA(1, 0, At, B0); PG8_BAR; PG8_SCHED;
            PG8_STAGE(PG8_SB(0, 1), b2 + hstep, voffB);
            PG8_WAIT_V(6); PG8_BAR; PG8_MMA(1, 1, At, B1); PG8_BAR;
            PG8_LDB(B0, 1, 0); PG8_SCHED; PG8_LDA(At, 1, 0); PG8_STAGE(PG8_SA(0, 1), a2 + hstep, voffA);
            PG8_WAIT_L(8); PG8_BAR; PG8_WAIT_L(0); PG8_MMA(0, 0, At, B0); PG8_BAR; PG8_SCHED;
            PG8_LDB(B1, 1, 1); PG8_STAGE(PG8_SB(1, 0), b3, voffB);
            PG8_BAR; PG8_WAIT_L(0); PG8_MMA(0, 1, At, B1); PG8_BAR;
            PG8_LDA(At, 1, 1); PG8_STAGE(PG8_SA(1, 0), a3, voffA);
            PG8_BAR; PG8_WAIT_L(0); PG8_MMA(1, 0, At, B0); PG8_BAR; PG8_SCHED;
            PG8_STAGE(PG8_SB(1, 1), b3 + hstep, voffB);
            PG8_WAIT_V(6); PG8_BAR; PG8_MMA(1, 1, At, B1); PG8_BAR;
            }
        }
        if constexpr (ALIGN_EPI) { if (wr == 0) PG8_BAR; }
        if constexpr (!Epi::AFTER_DRAIN) { E(acc, cur, wr, wc, fr, fq); S.done(cur); }
        if (!has_next) break;
#pragma unroll
        for (int a = 0; a < 2; ++a)
#pragma unroll
            for (int b = 0; b < 2; ++b)
#pragma unroll
                for (int m = 0; m < 4; ++m)
#pragma unroll
                    for (int n = 0; n < 2; ++n) acc[a][b][m][n] = (f32x4){0.f, 0.f, 0.f, 0.f};
        cur = nxt; cA = nA; cB = nB; ++ui;
        if constexpr (ALIGN_EPI) { if (wr == 1) PG8_BAR; }
    }
    PG8_WAIT_V(0);
    if constexpr (!ALIGN_EPI) { if (wr == 0) PG8_BAR; }
    PG8_BAR;
    if constexpr (Epi::AFTER_DRAIN) { E.fused(acc, cur, wr, wc, fr, fq, lds, wid, lane); S.done(cur); }
#undef PG8_SA
#undef PG8_SB
#undef PG8_STAGE
#undef PG8_LDA
#undef PG8_LDB
#undef PG8_MMA
#undef PG8_WAIT_V
#undef PG8_WAIT_L
#undef PG8_BAR
#undef PG8_SCHED
}
}

namespace pg8 {
__device__ __forceinline__ float silu_f(float x) { return x * __builtin_amdgcn_rcpf(1.0f + __builtin_amdgcn_exp2f(-1.4426950408889634f * x)); }
struct EpiResid {
    static constexpr bool PERM = true, AFTER_DRAIN = false;
    const float* X; float* O; const float* G;
    __device__ __forceinline__ void operator()(const f32x4 (&acc)[2][2][4][2], const Unit& u, int wr, int wc, int fr, int fq) const {
        const int row0 = u.pm * BM + wr * 64 + fr, col0 = u.pn * BM + wc * 32 + 8 * fq;
        const int b = (u.pm * BM) >> 11;
        const float* gp = G + (size_t)b * 12288 + col0;
        f32x4 gv[2][2];
#pragma unroll
        for (int bj = 0; bj < 2; ++bj)
#pragma unroll
            for (int n = 0; n < 2; ++n) gv[bj][n] = *(const f32x4*)(gp + bj * HALF + 4 * n);
#pragma unroll
        for (int ai = 0; ai < 2; ++ai)
#pragma unroll
            for (int m = 0; m < 4; ++m) { const size_t off = (size_t)(row0 + ai * HALF + m * 16) * 2048 + col0;
#pragma unroll
                for (int bj = 0; bj < 2; ++bj)
#pragma unroll
                    for (int n = 0; n < 2; ++n) { const f32x4 xv = *(const f32x4*)(X + off + bj * HALF + 4 * n); const f32x4 o = xv + gv[bj][n] * acc[ai][bj][m][n]; *(f32x4*)(O + off + bj * HALF + 4 * n) = o; } }
    }
};
struct EpiSwiGLU {
    static constexpr bool PERM = true, AFTER_DRAIN = false;
    bf16_t* Hm;
    __device__ __forceinline__ void operator()(const f32x4 (&acc)[2][2][4][2], const Unit& u, int wr, int wc, int fr, int fq) const {
        const int t = u.pn & 3; const int row0 = u.pm * BM + wr * 64 + fr, col0 = t * 128 + wc * 32 + 8 * fq;
#pragma unroll
        for (int ai = 0; ai < 2; ++ai)
#pragma unroll
            for (int m = 0; m < 4; ++m) { bf16_t* rowp = Hm + (size_t)(row0 + ai * HALF + m * 16) * 512 + col0;
                const f32x4 g0 = acc[ai][0][m][0], g1 = acc[ai][0][m][1], u0 = acc[ai][1][m][0], u1 = acc[ai][1][m][1];
                u32x4 w; w.x = cvt_pk_bf16(silu_f(g0[0]) * u0[0], silu_f(g0[1]) * u0[1]); w.y = cvt_pk_bf16(silu_f(g0[2]) * u0[2], silu_f(g0[3]) * u0[3]);
                w.z = cvt_pk_bf16(silu_f(g1[0]) * u1[0], silu_f(g1[1]) * u1[1]); w.w = cvt_pk_bf16(silu_f(g1[2]) * u1[2], silu_f(g1[3]) * u1[3]);
                *(u32x4*)rowp = w; }
    }
};
struct EpiDown {
    static constexpr bool PERM = true, AFTER_DRAIN = false;
    bf16_t* Y; const int* slot_tok; const float* slot_w;
    __device__ __forceinline__ void operator()(const f32x4 (&acc)[2][2][4][2], const Unit& u, int wr, int wc, int fr, int fq) const {
        const int t = u.pn & 7; const int row0 = u.pm * BM + wr * 64 + fr, col0 = t * 256 + wc * 32 + 8 * fq;
#pragma unroll
        for (int ai = 0; ai < 2; ++ai)
#pragma unroll
            for (int m = 0; m < 4; ++m) { const int slot = row0 + ai * HALF + m * 16; const int st = slot_tok[slot];
                if (st >= 0) { const float w = slot_w[slot]; bf16_t* rowp = Y + (size_t)st * 2048 + col0;
#pragma unroll
                    for (int bj = 0; bj < 2; ++bj) { const f32x4 v0 = acc[ai][bj][m][0] * w, v1 = acc[ai][bj][m][1] * w;
                        u32x4 o; o.x = cvt_pk_bf16(v0[0], v0[1]); o.y = cvt_pk_bf16(v0[2], v0[3]); o.z = cvt_pk_bf16(v1[0], v1[1]); o.w = cvt_pk_bf16(v1[2], v1[3]);
                        *(u32x4*)(rowp + bj * HALF) = o; } } }
    }
};
struct GroupedOrder {
    const int* rbe; int nunits, NT, G, c;
    __device__ __forceinline__ bool next(int i, Unit& u) const {
        const long L = (long)i * G + c; if (L >= nunits) return false;
        const int rb = (int)(L / NT), t = (int)(L % NT);
        const int e = __hip_atomic_load(rbe + rb, __ATOMIC_RELAXED, __HIP_MEMORY_SCOPE_AGENT);
        u.pm = rb; u.pn = e * NT + t; return true;
    }
    __device__ __forceinline__ void a_ready(const Unit&) const {}
    __device__ __forceinline__ void done(const Unit&) const {}
};
}

using pg8::bf16_t; using pg8::bf16x8; using pg8::f32x4; using pg8::u32x4;
typedef float f32x16 __attribute__((ext_vector_type(16)));
typedef short s16x4 __attribute__((ext_vector_type(4)));
typedef unsigned u32x2 __attribute__((ext_vector_type(2)));
#define LAS __attribute__((address_space(3)))

constexpr int NTHREADS = 512, NWAVES = 8;
constexpr int LDS_BYTES = 147456;
constexpr int DM = 2048, NTOK = 8192, SEQ = 2048, NB = 4;
constexpr int PW = 5888;
constexpr int PC_Q = 0, PC_KC = 1024, PC_VC = 1280, PC_KS = 1536, PC_VS = 1792, PC_KW = 2048, PC_VW = 2304;
constexpr int PC_GQ = 2560, PC_GK = 3072, PC_GV = 3584, PC_GO = 4608, PC_GATE = 5632, PC_LR = 5680;
constexpr int NKC = 16;
constexpr int CAP = 24576;
constexpr float LOG2E = 1.4426950408889634f;
constexpr float EPS = 1e-6f;

constexpr size_t MiB = 1u << 20;
constexpr size_t WS_CTL = 0, CTL_ZERO_BYTES = 64 * 1024;
constexpr size_t WS_MODP = 1 * MiB;
constexpr size_t WS_MODF = 5 * MiB;
constexpr size_t WS_A2G = WS_MODF + 256 * 1024;
constexpr size_t WS_SH2G = WS_A2G + 64 * 1024;
constexpr size_t WS_SMALL = 6 * MiB;
constexpr size_t WS_W1TK = WS_SMALL;
constexpr size_t WS_W1TV = WS_W1TK + 256 * 1024;
constexpr size_t WS_W2TK = WS_W1TV + 256 * 1024;
constexpr size_t WS_W2TV = WS_W2TK + 8 * 1024;
constexpr size_t WS_POSW1 = WS_W2TV + 8 * 1024;
constexpr size_t WS_KC = WS_POSW1 + 4 * 1024;
constexpr size_t WS_VCT = WS_KC + 256 * 1024;
constexpr size_t WS_WRH = WS_VCT + 256 * 1024;
constexpr size_t WS_WRL = WS_WRH + 192 * 1024;
constexpr size_t WS_ROUTE = 8 * MiB;
constexpr size_t WS_TOKE = WS_ROUTE;
constexpr size_t WS_TOKW = WS_TOKE + 64 * 1024;
constexpr size_t WS_TOKP = WS_TOKW + 64 * 1024;
constexpr size_t WS_SLOTT = WS_TOKP + 64 * 1024;
constexpr size_t WS_SLOTW = WS_SLOTT + 128 * 1024;
constexpr size_t WS_RBE = WS_SLOTW + 128 * 1024;
constexpr size_t WS_WIN = 10 * MiB;
constexpr size_t WS_WOUT = 33 * MiB;
constexpr size_t WS_WGU = 41 * MiB;
constexpr size_t WS_WD = 169 * MiB;
constexpr size_t WS_H = 233 * MiB;
constexpr size_t WS_P = 265 * MiB;
constexpr size_t WS_OW = 361 * MiB;
constexpr size_t WS_HMID = 377 * MiB;
constexpr size_t WS_END = 401 * MiB;
constexpr int CW_Q3 = 64, CW_Q4 = 128, CW_ECNT = 256, CW_BAR = 4096;

struct Params { const float* in[25]; float* out; unsigned char* ws; };

__device__ __forceinline__ float bf2f(unsigned short v) { return __uint_as_float((unsigned)v << 16); }
__device__ __forceinline__ unsigned pk2(float lo, float hi) {
    typedef float f2_t __attribute__((ext_vector_type(2))); typedef __bf16 b2_t __attribute__((ext_vector_type(2)));
    f2_t v = {lo, hi}; b2_t b = __builtin_convertvector(v, b2_t); return __builtin_bit_cast(unsigned, b);
}
__device__ __forceinline__ unsigned short f2bf(float f) { return (unsigned short)(pk2(f, 0.f) & 0xffffu); }
__device__ __forceinline__ float wave_sum(float v) {
#pragma unroll
    for (int o = 1; o < 64; o <<= 1) v += __shfl_xor(v, o);
    return v;
}
__device__ __forceinline__ float fexp2(float x) { return __builtin_amdgcn_exp2f(x); }
__device__ __forceinline__ float fexp(float x) { return __builtin_amdgcn_exp2f(x * LOG2E); }
__device__ __forceinline__ float sigmoid_f(float x) { return __builtin_amdgcn_rcpf(1.0f + fexp(-x)); }
__device__ __forceinline__ f32x16 mfma32(bf16x8 a, bf16x8 b, f32x16 c) { return __builtin_amdgcn_mfma_f32_32x32x16_bf16(a, b, c, 0, 0, 0); }
__device__ __forceinline__ f32x4 mfma16(bf16x8 a, bf16x8 b, f32x4 c) { return __builtin_amdgcn_mfma_f32_16x16x32_bf16(a, b, c, 0, 0, 0); }
__device__ __forceinline__ bf16x8 cat4(s16x4 a, s16x4 b) { return (bf16x8){a[0], a[1], a[2], a[3], b[0], b[1], b[2], b[3]}; }

template <class Map>
__device__ __forceinline__ void tr_item(const float* __restrict__ W, int K, int N, int k0, int n0, bf16_t* WT, const Map& map, float* scr, int lane) {
#pragma unroll 8
    for (int i = 0; i < 32; ++i) { const int kk = 2 * i + (lane >> 5); scr[kk * 33 + (lane & 31)] = W[(size_t)(k0 + kk) * N + n0 + (lane & 31)]; }
    asm volatile("s_waitcnt lgkmcnt(0)" ::: "memory");
    const int c = lane & 7;
#pragma unroll
    for (int j = 0; j < 4; ++j) { const int n = (lane >> 3) + 8 * j; const float* s = scr + (8 * c) * 33 + n; const int row = map(n0 + n);
        u32x4 o; o.x = pk2(s[0 * 33], s[1 * 33]); o.y = pk2(s[2 * 33], s[3 * 33]); o.z = pk2(s[4 * 33], s[5 * 33]); o.w = pk2(s[6 * 33], s[7 * 33]);
        if (row >= 0) *(u32x4*)(WT + (size_t)row * K + k0 + 8 * c) = o; }
    asm volatile("s_waitcnt lgkmcnt(0)" ::: "memory");
}
struct MapIn { __device__ __forceinline__ int operator()(int oc) const {
    if (oc < 2560) return oc; if (oc < 2608) return oc - 2560 + PC_GATE; if (oc < 5680) return oc - 48; return oc; } };
struct MapOff { int off; __device__ __forceinline__ int operator()(int n) const { return off + n; } };
struct MapGU { int base; __device__ __forceinline__ int operator()(int n) const { return base + (n >> 7) * 256 + (n & 127); } };

__device__ __forceinline__ void p0_prologue(const Params& p, unsigned char* lds, int tid, int lane, int wave) {
    const int G = gridDim.x, gw = blockIdx.x * NWAVES + wave, NGW = G * NWAVES;
    unsigned char* ws = p.ws;
    float* scr = (float*)(lds + wave * 8448);
    float* SC = (float*)(lds + 69632);
    for (int i = tid; i < 4 * 2048; i += NTHREADS) { const float v = p.in[1][i]; SC[i] = v * sigmoid_f(v); }
    __syncthreads();
    constexpr int nGEMV = NKC * 48, nTin = 32 * 178, nTout = 32 * 64, nTg = 32 * 32 * 16, nTd = 32 * 8 * 64, nTc1 = 64, nTc2 = 2, nZero = 192, nPos = 2;
    constexpr int nTotal = nGEMV + nTin + nTout + 2 * nTg + nTd + 2 * nTc1 + 2 * nTc2 + nZero + nPos;
    for (int it = gw; it < nTotal; it += NGW) {
        int r = it;
        if (r < nGEMV) {
            const int cgp = r % 48, kc = r / 48; const int col = cgp * 256 + lane * 4; const float* W = p.in[2] + (size_t)(kc * 128) * 12288 + col;
            f32x4 a0 = {0, 0, 0, 0}, a1 = a0, a2 = a0, a3 = a0;
#pragma unroll 8
            for (int kk = 0; kk < 128; ++kk) { const f32x4 w = *(const f32x4*)(W + (size_t)kk * 12288); const int k = kc * 128 + kk;
                a0 += w * SC[k]; a1 += w * SC[2048 + k]; a2 += w * SC[4096 + k]; a3 += w * SC[6144 + k]; }
            float* mp = (float*)(ws + WS_MODP) + (size_t)kc * 4 * 12288 + col;
            *(f32x4*)(mp) = a0; *(f32x4*)(mp + 12288) = a1; *(f32x4*)(mp + 2 * 12288) = a2; *(f32x4*)(mp + 3 * 12288) = a3;
            continue; }
        r -= nGEMV;
        if (r < nTin) { const int kb = r / 178, nb = r % 178; tr_item(p.in[5], 2048, 5696, 64 * kb, 32 * nb, (bf16_t*)(ws + WS_WIN), MapIn{}, scr, lane); continue; }
        r -= nTin;
        if (r < nTout) { const int kb = r / 64, nb = r % 64; tr_item(p.in[15], 2048, 2048, 64 * kb, 32 * nb, (bf16_t*)(ws + WS_WOUT), MapOff{0}, scr, lane); continue; }
        r -= nTout;
        if (r < 2 * nTg) { const int up = r / nTg; r -= up * nTg; const int e = r / 512, q = r % 512, kb = q / 16, nb = q % 16;
            tr_item(p.in[21 + up] + (size_t)e * 2048 * 512, 2048, 512, 64 * kb, 32 * nb, (bf16_t*)(ws + WS_WGU), MapGU{e * 1024 + up * 128}, scr, lane); continue; }
        r -= 2 * nTg;
        if (r < nTd) { const int e = r / 512, q = r % 512, kb = q / 64, nb = q % 64;
            tr_item(p.in[23] + (size_t)e * 512 * 2048, 512, 2048, 64 * kb, 32 * nb, (bf16_t*)(ws + WS_WD), MapOff{e * 2048}, scr, lane); continue; }
        r -= nTd;
        if (r < 2 * nTc1) { const int v = r / nTc1; r -= v * nTc1; const int kb = r / 2, nb = r % 2;
            tr_item(p.in[v ? 10 : 7], 2048, 64, 64 * kb, 32 * nb, (bf16_t*)(ws + (v ? WS_W1TV : WS_W1TK)), MapOff{0}, scr, lane); continue; }
        r -= 2 * nTc1;
        if (r < 2 * nTc2) { const int v = r / nTc2, nb = r % nTc2;
            tr_item(p.in[v ? 11 : 8], 64, 64, 0, 32 * nb, (bf16_t*)(ws + (v ? WS_W2TV : WS_W2TK)), MapOff{0}, scr, lane); continue; }
        r -= 2 * nTc2;
        if (r < nZero) { u32x4* z = (u32x4*)((bf16_t*)(ws + WS_WIN) + (size_t)(5696 + r) * 2048);
#pragma unroll
            for (int j = 0; j < 4; ++j) z[lane + 64 * j] = (u32x4){0u, 0u, 0u, 0u};
            continue; }
        r -= nZero;
        {
            const int v = r; const float* pos = p.in[v ? 9 : 6]; const float* w1 = p.in[v ? 10 : 7]; float s = 0.f;
            for (int k = 0; k < 2048; ++k) s += pos[k] * w1[(size_t)k * 64 + lane];
            ((float*)(ws + WS_POSW1))[v * 64 + lane] = s; }
    }
    { bf16_t* WH = (bf16_t*)(ws + WS_WRH); bf16_t* WL = (bf16_t*)(ws + WS_WRL);
      for (int idx = blockIdx.x * NTHREADS + tid; idx < 48 * 2048; idx += G * NTHREADS) { const int n = idx >> 11, k = idx & 2047;
          float w = 0.f; if (n < 32) w = p.in[19][(size_t)k * 32 + n]; else if (n < 36) w = p.in[17][(size_t)k * 4 + (n - 32)];
          const unsigned short h = f2bf(w); WH[idx] = h; WL[idx] = f2bf(w - bf2f(h)); } }
}

__device__ __forceinline__ void p1_norm1(const Params& p, unsigned char* lds, int tid, int lane, int wave) {
    unsigned char* ws = p.ws; const float* MODP = (const float*)(ws + WS_MODP); const float* bada = p.in[3];
    float* A1 = (float*)lds; float* SH1 = A1 + 2048;
    for (int rbk = blockIdx.x; rbk < 256; rbk += gridDim.x) {
        const int b = rbk >> 6;
        __syncthreads();
        for (int k = tid; k < 2048; k += NTHREADS) { float sh = bada[k], sc = bada[2048 + k];
            for (int kc = 0; kc < NKC; ++kc) { const float* mp = MODP + ((size_t)kc * 4 + b) * 12288; sh += mp[k]; sc += mp[2048 + k]; }
            A1[k] = p.in[4][k] * (1.0f + sc); SH1[k] = sh; }
        if (tid < 192) { const int idx = rbk * 192 + tid; const int bb = idx / 12288, j = idx % 12288; float s = bada[j];
            for (int kc = 0; kc < NKC; ++kc) s += MODP[((size_t)kc * 4 + bb) * 12288 + j];
            ((float*)(ws + WS_MODF))[idx] = s;
            if (j >= 6144 && j < 8192) ((float*)(ws + WS_SH2G))[bb * 2048 + (j - 6144)] = s;
            if (j >= 8192 && j < 10240) ((float*)(ws + WS_A2G))[bb * 2048 + (j - 8192)] = p.in[16][j - 8192] * (1.0f + s); }
        __syncthreads();
        for (int i = 0; i < 4; ++i) { const int row = rbk * 32 + wave * 4 + i; const f32x4* xr = (const f32x4*)(p.in[0] + (size_t)row * DM) + lane;
            f32x4 v[8]; float s = 0.f;
#pragma unroll
            for (int j = 0; j < 8; ++j) { v[j] = xr[64 * j]; s += (v[j].x * v[j].x + v[j].y * v[j].y) + (v[j].z * v[j].z + v[j].w * v[j].w); }
            const float rstd = rsqrtf(wave_sum(s) * (1.0f / DM) + EPS);
            u32x2* o = (u32x2*)((bf16_t*)(ws + WS_H) + (size_t)row * DM) + lane;
#pragma unroll
            for (int j = 0; j < 8; ++j) { const int k = 4 * lane + 256 * j; const f32x4 a = *(const f32x4*)(A1 + k), sh = *(const f32x4*)(SH1 + k);
                const f32x4 h = v[j] * rstd * a + sh; u32x2 w; w.x = pk2(h.x, h.y); w.y = pk2(h.z, h.w); o[64 * j] = w; } }
    }
}

__device__ __forceinline__ int fetch_item(unsigned* ctr, volatile int* slot, int tid) {
    __syncthreads();
    if (tid == 0) *slot = (int)atomicAdd(ctr, 1u);
    __syncthreads();
    return *slot;
}

constexpr int KSTR = 72;
constexpr float ATT_C1 = 0.125f * LOG2E;

template <int VSTR>
__device__ __forceinline__ void pv_acc(const bf16_t* Vt, int kvo, const f32x16& pt, int l31, int hi, f32x16& o0, f32x16& o1) {
#pragma unroll
    for (int s = 0; s < 2; ++s) {
        u32x4 pw; pw.x = pk2(pt[8 * s + 0], pt[8 * s + 1]); pw.y = pk2(pt[8 * s + 2], pt[8 * s + 3]); pw.z = pk2(pt[8 * s + 4], pt[8 * s + 5]); pw.w = pk2(pt[8 * s + 6], pt[8 * s + 7]);
        const bf16x8 pb = __builtin_bit_cast(bf16x8, pw);
        const bf16_t* v0 = Vt + (size_t)l31 * VSTR + kvo + 16 * s + 4 * hi;
        const bf16_t* v1 = v0 + 32 * VSTR;
        const bf16x8 a0 = cat4(*(const s16x4*)v0, *(const s16x4*)(v0 + 8));
        const bf16x8 a1 = cat4(*(const s16x4*)v1, *(const s16x4*)(v1 + 8));
        o0 = mfma32(a0, pb, o0); o1 = mfma32(a1, pb, o1);
    }
}
__device__ __forceinline__ void attn_tile_update(const bf16_t* Ks, const bf16_t* Vt, const bf16x8 (&qf)[4], int l31, int hi,
                                                 float dist0, float kscale, float dlo, float dhi, bool laneok, float slope2,
                                                 f32x16& o0, f32x16& o1, float& m, float& l) {
    f32x16 s0, s1;
#pragma unroll
    for (int r = 0; r < 16; ++r) { s0[r] = 0.f; s1[r] = 0.f; }
#pragma unroll
    for (int ks = 0; ks < 4; ++ks) {
        const bf16x8 a0 = *(const bf16x8*)(Ks + l31 * KSTR + ks * 16 + hi * 8);
        const bf16x8 a1 = *(const bf16x8*)(Ks + (32 + l31) * KSTR + ks * 16 + hi * 8);
        s0 = mfma32(a0, qf[ks], s0); s1 = mfma32(a1, qf[ks], s1);
    }
    const float dbase = dist0 - kscale * (float)(4 * hi);
    float mt = -1e30f;
#pragma unroll
    for (int r = 0; r < 16; ++r) { const float c = (float)((r & 3) + 8 * (r >> 2));
        const float d0 = dbase - kscale * c, d1 = d0 - kscale * 32.0f;
        const float v0 = s0[r] * ATT_C1 - slope2 * d0, v1 = s1[r] * ATT_C1 - slope2 * d1;
        const bool ok0 = laneok && (d0 >= dlo) && (d0 < dhi), ok1 = laneok && (d1 >= dlo) && (d1 < dhi);
        s0[r] = ok0 ? v0 : -1e30f; s1[r] = ok1 ? v1 : -1e30f;
        mt = fmaxf(mt, fmaxf(s0[r], s1[r])); }
    mt = fmaxf(mt, __shfl_xor(mt, 32));
    const float mnew = fmaxf(m, mt); const float alpha = fexp2(m - mnew); m = mnew;
    float ps = 0.f;
#pragma unroll
    for (int r = 0; r < 16; ++r) { const float p0 = s0[r] > -1e29f ? fexp2(s0[r] - mnew) : 0.f, p1 = s1[r] > -1e29f ? fexp2(s1[r] - mnew) : 0.f;
        s0[r] = p0; s1[r] = p1; ps += p0 + p1; }
    l = l * alpha + ps;
#pragma unroll
    for (int r = 0; r < 16; ++r) { o0[r] *= alpha; o1[r] *= alpha; }
    pv_acc<KSTR>(Vt, 0, s0, l31, hi, o0, o1);
    pv_acc<KSTR>(Vt, 32, s1, l31, hi, o0, o1);
}
__device__ __forceinline__ void stage_kv(const bf16_t* kg, const bf16_t* vg, size_t pitch, bf16_t* Ks, bf16_t* Vt, int tid) {
    const int skv = tid >> 3, sp = tid & 7;
    const bf16x8 kreg = *(const bf16x8*)(kg + (size_t)skv * pitch + sp * 8);
    const bf16x8 vreg = *(const bf16x8*)(vg + (size_t)skv * pitch + sp * 8);
    __syncthreads();
    *(bf16x8*)(Ks + skv * KSTR + sp * 8) = kreg;
#pragma unroll
    for (int jj = 0; jj < 8; ++jj) Vt[(sp * 8 + jj) * KSTR + skv] = (bf16_t)vreg[jj];
    __syncthreads();
}

__device__ __forceinline__ void nsa_window_unit(const Params& p, unsigned char* lds, int b, int g, int qblk, int tid, int lane, int wave) {
    const bf16_t* P = (const bf16_t*)(p.ws + WS_P);
    bf16_t* Ks = (bf16_t*)lds; bf16_t* Vt = Ks + 64 * KSTR;
    const int l31 = lane & 31, hi = lane >> 5, r = wave >> 1, qh = wave & 1, h = 4 * g + r;
    const int tq = 64 * qblk + 32 * qh + l31; const size_t row = (size_t)b * SEQ + tq;
    const bf16_t* qp = P + row * PW + PC_Q + h * 64;
    bf16x8 qf[4];
#pragma unroll
    for (int ks = 0; ks < 4; ++ks) qf[ks] = *(const bf16x8*)(qp + 16 * ks + 8 * hi);
    const float slope2 = exp2f(-0.5f * (float)(h + 1)) * LOG2E;
    f32x16 o0, o1;
#pragma unroll
    for (int i = 0; i < 16; ++i) { o0[i] = 0.f; o1[i] = 0.f; }
    float m = -1e30f, l = 0.f;
    const int j0 = qblk > 8 ? qblk - 8 : 0;
    for (int j = j0; j <= qblk; ++j) {
        const bf16_t* kg = P + ((size_t)b * SEQ + 64 * j) * PW + PC_KW + g * 64;
        stage_kv(kg, kg + (PC_VW - PC_KW), PW, Ks, Vt, tid);
        attn_tile_update(Ks, Vt, qf, l31, hi, (float)(tq - 64 * j), 1.0f, 0.0f, 512.0f, true, slope2, o0, o1, m, l);
    }
    l += __shfl_xor(l, 32);
    const float gate = sigmoid_f(bf2f(P[row * PW + PC_GATE + h * 3 + 2]));
    const float sc = gate / l;
    bf16_t* ow = (bf16_t*)(p.ws + WS_OW) + row * 1024 + h * 64;
#pragma unroll
    for (int c4 = 0; c4 < 4; ++c4) { const int d = 8 * c4 + 4 * hi;
        u32x2 w0; w0.x = pk2(o0[4 * c4] * sc, o0[4 * c4 + 1] * sc); w0.y = pk2(o0[4 * c4 + 2] * sc, o0[4 * c4 + 3] * sc); *(u32x2*)(ow + d) = w0;
        u32x2 w1; w1.x = pk2(o1[4 * c4] * sc, o1[4 * c4 + 1] * sc); w1.y = pk2(o1[4 * c4 + 2] * sc, o1[4 * c4 + 3] * sc); *(u32x2*)(ow + 32 + d) = w1; }
}

__device__ __forceinline__ void nsa_cmp_sel_unit(const Params& p, unsigned char* lds, int b, int g, int qblk, int tid, int lane, int wave) {
    const bf16_t* P = (const bf16_t*)(p.ws + WS_P);
    bf16_t* Ks = (bf16_t*)lds; bf16_t* Vt = Ks + 64 * KSTR;
    bf16_t* KsC = (bf16_t*)(lds + 18432); bf16_t* VtC = (bf16_t*)(lds + 18432 + 128 * KSTR * 2);
    float* Gs = (float*)(lds + 55296); float* Ls = Gs + 4 * 64 * 32; float* IMP = Ls + 4 * 64 * 32; unsigned* SELM = (unsigned*)(IMP + 64 * 32);
    const int l31 = lane & 31, hi = lane >> 5, r = wave >> 1, qh = wave & 1, h = 4 * g + r, ql = 32 * qh + l31;
    const int tq = 64 * qblk + ql; const size_t row = (size_t)b * SEQ + tq;
    const bf16_t* qp = P + row * PW + PC_Q + h * 64;
    bf16x8 qf[4];
#pragma unroll
    for (int ks = 0; ks < 4; ++ks) qf[ks] = *(const bf16x8*)(qp + 16 * ks + 8 * hi);
    const float slope2 = exp2f(-0.5f * (float)(h + 1)) * LOG2E;
    const float g_c = sigmoid_f(bf2f(P[row * PW + PC_GATE + h * 3 + 0])), g_s = sigmoid_f(bf2f(P[row * PW + PC_GATE + h * 3 + 1]));
    f32x16 acc0, acc1;
    {
        const bf16_t* kc = (const bf16_t*)(p.ws + WS_KC) + (size_t)(b * 4 + g) * 128 * 64;
        const bf16_t* vct = (const bf16_t*)(p.ws + WS_VCT) + (size_t)(b * 4 + g) * 64 * 128;
        __syncthreads();
        for (int i = tid; i < 1024; i += NTHREADS) { const int n = i >> 3, sp = i & 7; *(bf16x8*)(KsC + n * KSTR + sp * 8) = *(const bf16x8*)(kc + n * 64 + sp * 8); }
        for (int i = tid; i < 1024; i += NTHREADS) { const int d = i >> 4, sp = i & 15; *(bf16x8*)(VtC + d * 136 + sp * 8) = *(const bf16x8*)(vct + d * 128 + sp * 8); }
        __syncthreads();
        f32x16 s[4];
#pragma unroll
        for (int t = 0; t < 4; ++t) {
#pragma unroll
            for (int i = 0; i < 16; ++i) s[t][i] = 0.f;
#pragma unroll
            for (int ks = 0; ks < 4; ++ks) { const bf16x8 a = *(const bf16x8*)(KsC + (32 * t + l31) * KSTR + ks * 16 + hi * 8); s[t] = mfma32(a, qf[ks], s[t]); } }
        const float dbase = (float)tq - 15.5f - 64.0f * (float)hi;
        float mt = -1e30f;
#pragma unroll
        for (int t = 0; t < 4; ++t)
#pragma unroll
            for (int i = 0; i < 16; ++i) { const float c = (float)(32 * t + (i & 3) + 8 * (i >> 2)); const float d = dbase - 16.0f * c;
                const float v = s[t][i] * ATT_C1 - slope2 * d; s[t][i] = (d >= 15.5f) ? v : -1e30f; mt = fmaxf(mt, s[t][i]); }
        mt = fmaxf(mt, __shfl_xor(mt, 32));
        float ps = 0.f;
#pragma unroll
        for (int t = 0; t < 4; ++t)
#pragma unroll
            for (int i = 0; i < 16; ++i) { const float pv = s[t][i] > -1e29f ? fexp2(s[t][i] - mt) : 0.f; s[t][i] = pv; ps += pv; }
        ps += __shfl_xor(ps, 32);
        const float linv = ps > 0.f ? 1.0f / ps : 0.f;
#pragma unroll
        for (int t = 0; t < 4; ++t)
#pragma unroll
            for (int i = 0; i < 16; ++i) s[t][i] *= linv;
#pragma unroll
        for (int t = 0; t < 4; ++t)
#pragma unroll
            for (int c4 = 0; c4 < 4; ++c4) { const int jj = 8 * t + 2 * c4 + hi; const int o = (r * 64 + ql) * 32 + jj;
                Gs[o] = (s[t][4 * c4] + s[t][4 * c4 + 1]) + (s[t][4 * c4 + 2] + s[t][4 * c4 + 3]); Ls[o] = s[t][4 * c4 + 3]; }
        f32x16 o0, o1;
#pragma unroll
        for (int i = 0; i < 16; ++i) { o0[i] = 0.f; o1[i] = 0.f; }
#pragma unroll
        for (int t = 0; t < 4; ++t) pv_acc<136>(VtC, 32 * t, s[t], l31, hi, o0, o1);
#pragma unroll
        for (int i = 0; i < 16; ++i) { acc0[i] = g_c * o0[i]; acc1[i] = g_c * o1[i]; }
    }
    __syncthreads();
    for (int idx = tid; idx < 64 * 32; idx += NTHREADS) { const int q = idx >> 5, j = idx & 31; float v = 0.f;
#pragma unroll
        for (int hh = 0; hh < 4; ++hh) { v += Gs[(hh * 64 + q) * 32 + j]; if (j > 0) v += Ls[(hh * 64 + q) * 32 + j - 1]; }
        IMP[idx] = v; }
    __syncthreads();
#pragma unroll 1
    for (int it = 0; it < 4; ++it) { const int q = 2 * (8 * it + wave) + (lane >> 5), j = lane & 31; bool sel;
        if (qblk < 16) sel = (j <= qblk);
        else { const bool forced = (j == 0) || (j == qblk) || (j == qblk - 1); const bool cand = (j >= 1) && (j <= qblk - 2);
            const float v = IMP[q * 32 + j]; int rank = 0;
            for (int j2 = 1; j2 <= qblk - 2; ++j2) { const float v2 = IMP[q * 32 + j2]; rank += (v2 > v || (v2 == v && j2 < j)) ? 1 : 0; }
            sel = forced || (cand && rank < 13); }
        const unsigned long long bm = __ballot(sel);
        if (j == 0) SELM[q] = (lane >> 5) ? (unsigned)(bm >> 32) : (unsigned)bm; }
    __syncthreads();
    unsigned um = 0u;
    for (int i = 0; i < 64; ++i) um |= SELM[i];
    const unsigned mymask = SELM[ql];
    {
        f32x16 o0, o1;
#pragma unroll
        for (int i = 0; i < 16; ++i) { o0[i] = 0.f; o1[i] = 0.f; }
        float m = -1e30f, l = 0.f;
        for (int j = 0; j <= qblk; ++j) {
            if (!((um >> j) & 1u)) continue;
            const bf16_t* kg = P + ((size_t)b * SEQ + 64 * j) * PW + PC_KS + g * 64;
            stage_kv(kg, kg + (PC_VS - PC_KS), PW, Ks, Vt, tid);
            attn_tile_update(Ks, Vt, qf, l31, hi, (float)(tq - 64 * j), 1.0f, 0.0f, 1e9f, ((mymask >> j) & 1u) != 0u, slope2, o0, o1, m, l);
        }
        l += __shfl_xor(l, 32);
        const float sc = g_s / l;
#pragma unroll
        for (int i = 0; i < 16; ++i) { acc0[i] += sc * o0[i]; acc1[i] += sc * o1[i]; }
    }
    const bf16_t* ow = (const bf16_t*)(p.ws + WS_OW) + row * 1024 + h * 64;
    bf16_t* mx = (bf16_t*)(p.ws + WS_H) + row * DM + h * 64;
#pragma unroll
    for (int c4 = 0; c4 < 4; ++c4) { const int d = 8 * c4 + 4 * hi;
        const u32x2 a = *(const u32x2*)(ow + d), bq = *(const u32x2*)(ow + 32 + d);
        const float w0 = acc0[4 * c4] + __uint_as_float(a.x << 16), w1 = acc0[4 * c4 + 1] + __uint_as_float(a.x & 0xffff0000u), w2 = acc0[4 * c4 + 2] + __uint_as_float(a.y << 16), w3 = acc0[4 * c4 + 3] + __uint_as_float(a.y & 0xffff0000u);
        const float x0 = acc1[4 * c4] + __uint_as_float(bq.x << 16), x1 = acc1[4 * c4 + 1] + __uint_as_float(bq.x & 0xffff0000u), x2 = acc1[4 * c4 + 2] + __uint_as_float(bq.y << 16), x3 = acc1[4 * c4 + 3] + __uint_as_float(bq.y & 0xffff0000u);
        u32x2 o; o.x = pk2(w0, w1); o.y = pk2(w2, w3); *(u32x2*)(mx + d) = o;
        u32x2 o2; o2.x = pk2(x0, x1); o2.y = pk2(x2, x3); *(u32x2*)(mx + 32 + d) = o2; }
}

__device__ __forceinline__ float gelu_tanh(float x) { const float u = 0.7978845608028654f * (x + 0.044715f * x * x * x); const float e = fexp(2.0f * u); return 0.5f * x * (2.0f - 2.0f / (e + 1.0f)); }
__device__ __forceinline__ void nsa_compress_unit(const Params& p, unsigned char* lds, int cu, int tid, int lane, int wave) {
    const int kv = cu >> 7, b = (cu >> 5) & 3, g = (cu >> 3) & 3, nt = cu & 7;
    const bf16_t* P = (const bf16_t*)(p.ws + WS_P);
    const bf16_t* W1T = (const bf16_t*)(p.ws + (kv ? WS_W1TV : WS_W1TK)); const bf16_t* W2T = (const bf16_t*)(p.ws + (kv ? WS_W2TV : WS_W2TK));
    float* PART = (float*)lds;
    bf16_t* HS = (bf16_t*)(lds + 32768);
    const int fr = lane & 15, fq = lane >> 4;
    int n = 16 * nt + fr; if (n > 126) n = 126;
    const int colbase = (kv ? PC_VC : PC_KC) + g * 64;
    f32x4 acc[4];
#pragma unroll
    for (int i = 0; i < 4; ++i) acc[i] = (f32x4){0.f, 0.f, 0.f, 0.f};
#pragma unroll
    for (int ks = 0; ks < 8; ++ks) { const int kg = 256 * wave + 32 * ks + 8 * fq; const int t = kg >> 6, d = kg & 63;
        const bf16x8 a = *(const bf16x8*)(P + ((size_t)b * SEQ + 16 * n + t) * PW + colbase + d);
#pragma unroll
        for (int ntile = 0; ntile < 4; ++ntile) { const bf16x8 bb = *(const bf16x8*)(W1T + (size_t)(ntile * 16 + fr) * 2048 + kg); acc[ntile] = mfma16(a, bb, acc[ntile]); } }
    __syncthreads();
#pragma unroll
    for (int ntile = 0; ntile < 4; ++ntile)
#pragma unroll
        for (int i = 0; i < 4; ++i) PART[(wave * 16 + fq * 4 + i) * 64 + ntile * 16 + fr] = acc[ntile][i];
    __syncthreads();
    { const int rr = tid >> 5, c2 = (tid & 31) * 2; float v0 = ((const float*)(p.ws + WS_POSW1))[kv * 64 + c2], v1 = ((const float*)(p.ws + WS_POSW1))[kv * 64 + c2 + 1];
#pragma unroll
      for (int w = 0; w < 8; ++w) { v0 += PART[(w * 16 + rr) * 64 + c2]; v1 += PART[(w * 16 + rr) * 64 + c2 + 1]; }
      *(unsigned*)(HS + rr * KSTR + c2) = pk2(gelu_tanh(v0), gelu_tanh(v1)); }
    __syncthreads();
    if (wave < 4) { f32x4 a2 = (f32x4){0.f, 0.f, 0.f, 0.f};
#pragma unroll
        for (int s = 0; s < 2; ++s) { const bf16x8 a = *(const bf16x8*)(HS + fr * KSTR + 32 * s + 8 * fq); const bf16x8 bb = *(const bf16x8*)(W2T + (wave * 16 + fr) * 64 + 32 * s + 8 * fq); a2 = mfma16(a, bb, a2); }
        const int d = wave * 16 + fr;
#pragma unroll
        for (int i = 0; i < 4; ++i) { const int nn = 16 * nt + fq * 4 + i; const float val = nn <= 126 ? a2[i] : 0.f;
            if (kv == 0) ((bf16_t*)(p.ws + WS_KC))[((size_t)(b * 4 + g) * 128 + nn) * 64 + d] = f2bf(val);
            else ((bf16_t*)(p.ws + WS_VCT))[((size_t)(b * 4 + g) * 64 + d) * 128 + nn] = f2bf(val); } }
}

__device__ __forceinline__ void gla_unit(const Params& p, unsigned char* lds, int b, int h, int tid, int lane, int wave) {
    const bf16_t* P = (const bf16_t*)(p.ws + WS_P);
    float* BL = (float*)lds;
    bf16_t* QT = (bf16_t*)(lds + 32768);
    bf16_t* KH = (bf16_t*)(lds + 50176);
    bf16_t* KTt = (bf16_t*)(lds + 67584);
    bf16_t* VT = (bf16_t*)(lds + 86016);
    bf16_t* AT = (bf16_t*)(lds + 122880);
    float* SEG = (float*)(lds + 132096);
    float* EBL = (float*)(lds + 134144);
    float* LR = (float*)(lds + 122880);
    float* SSQ = (float*)(lds + 134656);
    const int l31 = lane & 31, hi = lane >> 5;
    const int gk = tid & 127, seg = tid >> 7;
    float* WG = (float*)(lds + 136704);
    const float bg = p.in[13][h * 128 + gk];
    __syncthreads();
    for (int i = tid; i < 2048; i += NTHREADS) WG[i] = p.in[12][(i >> 7) * 512 + h * 128 + (i & 127)];
    f32x16 S[4];
#pragma unroll
    for (int t = 0; t < 4; ++t)
#pragma unroll
        for (int i = 0; i < 16; ++i) S[t][i] = 0.f;
    const float qscale = 0.08838834764831845f;
    for (int c = 0; c < 32; ++c) {
        const size_t row0 = (size_t)b * SEQ + 64 * c;
        __syncthreads();
        for (int i = tid; i < 1024; i += NTHREADS) LR[i] = bf2f(P[(row0 + (i >> 4)) * PW + PC_LR + (i & 15)]);
        __syncthreads();
        { float run = 0.f;
          for (int ii = 0; ii < 16; ++ii) { const int i = 16 * seg + ii; float z = bg;
#pragma unroll
              for (int r = 0; r < 16; ++r) z += LR[i * 16 + r] * WG[r * 128 + gk];
              const float la = (fminf(z, 0.f) - __logf(1.0f + __expf(-fabsf(z)))) * 0.0625f;
              run += la; BL[i * 128 + gk] = run; }
          SEG[seg * 128 + gk] = run; }
        __syncthreads();
        {
            if (tid < 128) EBL[tid] = __expf(SEG[tid] + SEG[128 + tid] + SEG[256 + tid] + SEG[384 + tid]);
#pragma unroll 1
            for (int ps = 0; ps < 2; ++ps) { const int i = 32 * ps + (tid >> 4), k8 = (tid & 15) * 8; const int sg = i >> 4;
                const bf16x8 qv = *(const bf16x8*)(P + (row0 + i) * PW + PC_GQ + h * 128 + k8);
                const bf16x8 kv = *(const bf16x8*)(P + (row0 + i) * PW + PC_GK + h * 128 + k8);
                float qe[8], ke[8];
#pragma unroll
                for (int j = 0; j < 8; ++j) { const int k = k8 + j; float pre = 0.f, tot = 0.f;
#pragma unroll
                    for (int s2 = 0; s2 < 4; ++s2) { const float sv = SEG[s2 * 128 + k]; tot += sv; if (s2 < sg) pre += sv; }
                    const float bb = BL[i * 128 + k] + pre; const float kf = bf2f((unsigned short)kv[j]);
                    qe[j] = bf2f((unsigned short)qv[j]) * qscale * __expf(bb); ke[j] = kf * __expf(-bb);
                    KTt[k * KSTR + i] = f2bf(kf * __expf(tot - bb)); }
                u32x4 w; w.x = pk2(qe[0], qe[1]); w.y = pk2(qe[2], qe[3]); w.z = pk2(qe[4], qe[5]); w.w = pk2(qe[6], qe[7]); *(u32x4*)(QT + i * 136 + k8) = w;
                u32x4 w2; w2.x = pk2(ke[0], ke[1]); w2.y = pk2(ke[2], ke[3]); w2.z = pk2(ke[4], ke[5]); w2.w = pk2(ke[6], ke[7]); *(u32x4*)(KH + i * 136 + k8) = w2; }
#pragma unroll 1
            for (int ps = 0; ps < 4; ++ps) { const int i = 16 * ps + (tid >> 5), d8 = (tid & 31) * 8;
                const bf16x8 vv = *(const bf16x8*)(P + (row0 + i) * PW + PC_GV + h * 256 + d8);
#pragma unroll
                for (int j = 0; j < 8; ++j) VT[(d8 + j) * KSTR + i] = (bf16_t)vv[j]; }
        }
        __syncthreads();
        if (wave < 4) { const int jt = wave >> 1, itl = wave & 1;
            f32x16 cacc;
#pragma unroll
            for (int i = 0; i < 16; ++i) cacc[i] = 0.f;
            if (!(jt == 1 && itl == 0)) {
#pragma unroll
                for (int ks = 0; ks < 8; ++ks) { const bf16x8 a = *(const bf16x8*)(KH + (32 * jt + l31) * 136 + 16 * ks + 8 * hi); const bf16x8 bb = *(const bf16x8*)(QT + (32 * itl + l31) * 136 + 16 * ks + 8 * hi); cacc = mfma32(a, bb, cacc); } }
            const int i = 32 * itl + l31;
#pragma unroll
            for (int c4 = 0; c4 < 4; ++c4) { const int jb = 32 * jt + 8 * c4 + 4 * hi;
                const float a0 = (jb + 0 <= i) ? cacc[4 * c4 + 0] : 0.f, a1 = (jb + 1 <= i) ? cacc[4 * c4 + 1] : 0.f, a2 = (jb + 2 <= i) ? cacc[4 * c4 + 2] : 0.f, a3 = (jb + 3 <= i) ? cacc[4 * c4 + 3] : 0.f;
                u32x2 w; w.x = pk2(a0, a1); w.y = pk2(a2, a3); *(u32x2*)(AT + i * KSTR + jb) = w; } }
        __syncthreads();
        f32x16 oT[2];
#pragma unroll
        for (int i = 0; i < 16; ++i) { oT[0][i] = 0.f; oT[1][i] = 0.f; }
#pragma unroll
        for (int dkt = 0; dkt < 4; ++dkt) {
#pragma unroll
            for (int s = 0; s < 2; ++s) {
                u32x4 sw; sw.x = pk2(S[dkt][8 * s + 0], S[dkt][8 * s + 1]); sw.y = pk2(S[dkt][8 * s + 2], S[dkt][8 * s + 3]); sw.z = pk2(S[dkt][8 * s + 4], S[dkt][8 * s + 5]); sw.w = pk2(S[dkt][8 * s + 6], S[dkt][8 * s + 7]);
                const bf16x8 sa = __builtin_bit_cast(bf16x8, sw);
                const bf16_t* qb0 = QT + l31 * 136 + 32 * dkt + 16 * s + 4 * hi; const bf16_t* qb1 = qb0 + 32 * 136;
                oT[0] = mfma32(sa, cat4(*(const s16x4*)qb0, *(const s16x4*)(qb0 + 8)), oT[0]);
                oT[1] = mfma32(sa, cat4(*(const s16x4*)qb1, *(const s16x4*)(qb1 + 8)), oT[1]); }
            __builtin_amdgcn_sched_barrier(0); }
#pragma unroll
        for (int s4 = 0; s4 < 4; ++s4) { const bf16x8 a = *(const bf16x8*)(VT + (32 * wave + l31) * KSTR + 16 * s4 + 8 * hi);
            oT[0] = mfma32(a, *(const bf16x8*)(AT + l31 * KSTR + 16 * s4 + 8 * hi), oT[0]);
            oT[1] = mfma32(a, *(const bf16x8*)(AT + (32 + l31) * KSTR + 16 * s4 + 8 * hi), oT[1]); }
        __builtin_amdgcn_sched_barrier(0);
#pragma unroll
        for (int dkt = 0; dkt < 4; ++dkt) {
#pragma unroll
            for (int i = 0; i < 16; ++i) S[dkt][i] *= EBL[32 * dkt + (i & 3) + 8 * (i >> 2) + 4 * hi];
#pragma unroll
            for (int s4 = 0; s4 < 4; ++s4) { const bf16x8 a = *(const bf16x8*)(KTt + (32 * dkt + l31) * KSTR + 16 * s4 + 8 * hi); const bf16x8 bb = *(const bf16x8*)(VT + (32 * wave + l31) * KSTR + 16 * s4 + 8 * hi); S[dkt] = mfma32(a, bb, S[dkt]); }
            __builtin_amdgcn_sched_barrier(0); }
        { float q0 = 0.f, q1 = 0.f;
#pragma unroll
          for (int i = 0; i < 16; ++i) { q0 += oT[0][i] * oT[0][i]; q1 += oT[1][i] * oT[1][i]; }
          q0 += __shfl_xor(q0, 32); q1 += __shfl_xor(q1, 32);
          if (hi == 0) { SSQ[wave * 64 + l31] = q0; SSQ[wave * 64 + 32 + l31] = q1; } }
        __syncthreads();
#pragma unroll
        for (int itl = 0; itl < 2; ++itl) { const int i = 32 * itl + l31; float tot = 0.f;
#pragma unroll
            for (int w = 0; w < 8; ++w) tot += SSQ[w * 64 + i];
            const float rstd = rsqrtf(tot * (1.0f / 256.0f) + EPS);
            const bf16_t* og = P + (row0 + i) * PW + PC_GO + h * 256 + 32 * wave;
            bf16_t* mx = (bf16_t*)(p.ws + WS_H) + (row0 + i) * DM + 1024 + h * 256 + 32 * wave;
#pragma unroll
            for (int c4 = 0; c4 < 4; ++c4) { const int d = 8 * c4 + 4 * hi; const u32x2 gq = *(const u32x2*)(og + d);
                const f32x4 nw = *(const f32x4*)(p.in[14] + 32 * wave + d);
                const float g0 = __uint_as_float(gq.x << 16), g1 = __uint_as_float(gq.x & 0xffff0000u), g2 = __uint_as_float(gq.y << 16), g3 = __uint_as_float(gq.y & 0xffff0000u);
                const float v0 = oT[itl][4 * c4] * rstd * nw.x * pg8::silu_f(g0), v1 = oT[itl][4 * c4 + 1] * rstd * nw.y * pg8::silu_f(g1), v2 = oT[itl][4 * c4 + 2] * rstd * nw.z * pg8::silu_f(g2), v3 = oT[itl][4 * c4 + 3] * rstd * nw.w * pg8::silu_f(g3);
                u32x2 o; o.x = pk2(v0, v1); o.y = pk2(v2, v3); *(u32x2*)(mx + d) = o; }
            __builtin_amdgcn_sched_barrier(0); }
    }
}

__device__ __forceinline__ void p6_norm2_route(const Params& p, unsigned char* lds, int tid, int lane, int wave) {
    unsigned char* ws = p.ws; const float* X2 = p.out; bf16_t* H2 = (bf16_t*)(ws + WS_H);
    const bf16_t* WRH = (const bf16_t*)(ws + WS_WRH); const bf16_t* WRL = (const bf16_t*)(ws + WS_WRL);
    float* LG = (float*)(lds + wave * 4096);
    const int fr = lane & 15, fq = lane >> 4;
    unsigned* ctl = (unsigned*)(ws + WS_CTL);
    for (int task = wave * gridDim.x + blockIdx.x; task < 512; task += NWAVES * gridDim.x) {
        const int row0 = 16 * task, b = row0 >> 11;
        float myrstd = 0.f;
        for (int rr = 0; rr < 16; ++rr) { const f32x4* xr = (const f32x4*)(X2 + (size_t)(row0 + rr) * DM) + lane; float s = 0.f;
#pragma unroll
            for (int j = 0; j < 8; ++j) { const f32x4 v = xr[64 * j]; s += (v.x * v.x + v.y * v.y) + (v.z * v.z + v.w * v.w); }
            const float tot = wave_sum(s); if (fr == rr) myrstd = rsqrtf(tot * (1.0f / DM) + EPS); }
        const float* xrow = X2 + (size_t)(row0 + fr) * DM; const float* a2 = (const float*)(ws + WS_A2G) + b * 2048; const float* s2 = (const float*)(ws + WS_SH2G) + b * 2048;
        bf16_t* hrow = H2 + (size_t)(row0 + fr) * DM;
        f32x4 acc[3];
#pragma unroll
        for (int i = 0; i < 3; ++i) acc[i] = (f32x4){0.f, 0.f, 0.f, 0.f};
#pragma unroll 2
        for (int ks = 0; ks < 64; ++ks) { const int k0 = 32 * ks + 8 * fq;
            const f32x4 x0 = *(const f32x4*)(xrow + k0), x1 = *(const f32x4*)(xrow + k0 + 4), aa0 = *(const f32x4*)(a2 + k0), aa1 = *(const f32x4*)(a2 + k0 + 4), ss0 = *(const f32x4*)(s2 + k0), ss1 = *(const f32x4*)(s2 + k0 + 4);
            const f32x4 h0 = x0 * myrstd * aa0 + ss0, h1 = x1 * myrstd * aa1 + ss1;
            u32x4 hw; hw.x = pk2(h0.x, h0.y); hw.y = pk2(h0.z, h0.w); hw.z = pk2(h1.x, h1.y); hw.w = pk2(h1.z, h1.w);
            *(u32x4*)(hrow + k0) = hw;
            u32x4 lw; lw.x = pk2(h0.x - __uint_as_float(hw.x << 16), h0.y - __uint_as_float(hw.x & 0xffff0000u)); lw.y = pk2(h0.z - __uint_as_float(hw.y << 16), h0.w - __uint_as_float(hw.y & 0xffff0000u));
            lw.z = pk2(h1.x - __uint_as_float(hw.z << 16), h1.y - __uint_as_float(hw.z & 0xffff0000u)); lw.w = pk2(h1.z - __uint_as_float(hw.w << 16), h1.w - __uint_as_float(hw.w & 0xffff0000u));
            const bf16x8 hf = __builtin_bit_cast(bf16x8, hw), lf = __builtin_bit_cast(bf16x8, lw);
#pragma unroll
            for (int nt = 0; nt < 3; ++nt) { const bf16x8 bh = *(const bf16x8*)(WRH + (size_t)(nt * 16 + fr) * 2048 + k0), bl = *(const bf16x8*)(WRL + (size_t)(nt * 16 + fr) * 2048 + k0);
                acc[nt] = mfma16(hf, bh, acc[nt]); acc[nt] = mfma16(hf, bl, acc[nt]); acc[nt] = mfma16(lf, bh, acc[nt]); } }
#pragma unroll
        for (int nt = 0; nt < 3; ++nt)
#pragma unroll
            for (int i = 0; i < 4; ++i) LG[(fq * 4 + i) * 49 + nt * 16 + fr] = acc[nt][i];
        asm volatile("s_waitcnt lgkmcnt(0)" ::: "memory");
        if (lane < 16) { const float* lg = LG + lane * 49; const int tok = row0 + lane;
            float gl[4]; int grp = 0; float gmax = -1e30f;
#pragma unroll
            for (int j = 0; j < 4; ++j) { gl[j] = lg[32 + j] + p.in[18][j]; if (gl[j] > gmax) { gmax = gl[j]; grp = j; } }
            float gs = 0.f;
#pragma unroll
            for (int j = 0; j < 4; ++j) gs += __expf(gl[j] - gmax);
            const float grp_p = 1.0f / gs;
            float v1 = -1e30f, v2 = -1e30f; int i1 = 0, i2 = 0;
            for (int j = 0; j < 8; ++j) { const float v = lg[grp * 8 + j] + p.in[20][grp * 8 + j];
                if (v > v1) { v2 = v1; i2 = i1; v1 = v; i1 = j; } else if (v > v2) { v2 = v; i2 = j; } }
            const float e2 = __expf(v2 - v1); const float w1 = grp_p / (1.0f + e2), w2 = grp_p * e2 / (1.0f + e2);
            const int ea = grp * 8 + i1, eb = grp * 8 + i2;
            const int pa = (int)atomicAdd(ctl + CW_ECNT + 16 * ea, 1u), pb = (int)atomicAdd(ctl + CW_ECNT + 16 * eb, 1u);
            int* te = (int*)(ws + WS_TOKE); float* tw = (float*)(ws + WS_TOKW); int* tp = (int*)(ws + WS_TOKP);
            te[2 * tok] = ea; te[2 * tok + 1] = eb; tw[2 * tok] = w1; tw[2 * tok + 1] = w2; tp[2 * tok] = pa; tp[2 * tok + 1] = pb; }
        asm volatile("s_waitcnt lgkmcnt(0)" ::: "memory");
    }
}

__device__ __forceinline__ void p7_dispatch(const Params& p, unsigned char* lds, int tid, int lane, int wave) {
    unsigned char* ws = p.ws; unsigned* ctl = (unsigned*)(ws + WS_CTL);
    int* PST = (int*)lds;
    volatile int* PSTv = (volatile int*)PST;
    if (tid < 32) PSTv[64 + tid] = (int)__hip_atomic_load(ctl + CW_ECNT + 16 * tid, __ATOMIC_RELAXED, __HIP_MEMORY_SCOPE_AGENT);
    __syncthreads();
    if (tid == 0) { int acc = 0;
#pragma unroll 1
        for (int e = 0; e < 32; ++e) { const int c = PSTv[64 + e]; PSTv[e] = acc; acc += (c + 255) & ~255; } PSTv[32] = acc; }
    __syncthreads();
    int* slot_tok = (int*)(ws + WS_SLOTT); float* slot_w = (float*)(ws + WS_SLOTW); int* rbe = (int*)(ws + WS_RBE);
    if (blockIdx.x == 0) {
        const int nrb = PST[32] >> 8;
        if (tid == 0) rbe[128] = nrb;
        for (int rb = tid; rb < nrb; rb += NTHREADS) { int e = 0;
#pragma unroll 1
            for (int q = 0; q < 32; ++q) if (PSTv[q] <= rb * 256 && rb * 256 < PSTv[q + 1]) e = q;
            rbe[rb] = e; }
#pragma unroll 1
        for (int e = 0; e < 32; ++e) { const int s0 = PSTv[e] + PSTv[64 + e], s1 = PSTv[e + 1]; for (int s = s0 + tid; s < s1; s += NTHREADS) slot_tok[s] = -1; }
    }
    const int gw = blockIdx.x * NWAVES + wave, NGW = gridDim.x * NWAVES;
    const int* te = (const int*)(ws + WS_TOKE); const float* tw = (const float*)(ws + WS_TOKW); const int* tp = (const int*)(ws + WS_TOKP);
    const bf16_t* H2 = (const bf16_t*)(ws + WS_H); bf16_t* XS = (bf16_t*)(ws + WS_P);
    for (int pair = gw; pair < 16384; pair += NGW) { const int tok = pair >> 1; const int e = te[pair], pos = tp[pair]; const int slot = PST[e] + pos;
        const u32x4* src = (const u32x4*)(H2 + (size_t)tok * DM) + lane; u32x4* dst = (u32x4*)(XS + (size_t)slot * DM) + lane;
#pragma unroll
        for (int j = 0; j < 4; ++j) dst[64 * j] = src[64 * j];
        if (lane == 0) { slot_tok[slot] = pair; slot_w[slot] = tw[pair]; } }
}

__device__ __forceinline__ void p10_final(const Params& p, int tid, int lane, int wave) {
    unsigned char* ws = p.ws; const bf16_t* Y = (const bf16_t*)(ws + WS_P); const float* MODF = (const float*)(ws + WS_MODF);
    const int gw = blockIdx.x * NWAVES + wave, NGW = gridDim.x * NWAVES;
    for (int row = gw; row < NTOK; row += NGW) { const int b = row >> 11;
        f32x4* xr = (f32x4*)(p.out + (size_t)row * DM) + lane; const u32x2* y0 = (const u32x2*)(Y + (size_t)(2 * row) * DM) + lane; const u32x2* y1 = (const u32x2*)(Y + (size_t)(2 * row + 1) * DM) + lane;
        const f32x4* g2 = (const f32x4*)(MODF + (size_t)b * 12288 + 10240) + lane; const f32x4* nf = (const f32x4*)p.in[24] + lane;
        f32x4 v[8]; float s = 0.f;
#pragma unroll
        for (int j = 0; j < 8; ++j) { const f32x4 x = xr[64 * j]; const u32x2 a = y0[64 * j], c = y1[64 * j]; const f32x4 gg = g2[64 * j];
            f32x4 ys; ys.x = __uint_as_float(a.x << 16) + __uint_as_float(c.x << 16); ys.y = __uint_as_float(a.x & 0xffff0000u) + __uint_as_float(c.x & 0xffff0000u);
            ys.z = __uint_as_float(a.y << 16) + __uint_as_float(c.y << 16); ys.w = __uint_as_float(a.y & 0xffff0000u) + __uint_as_float(c.y & 0xffff0000u);
            v[j] = x + gg * ys; s += (v[j].x * v[j].x + v[j].y * v[j].y) + (v[j].z * v[j].z + v[j].w * v[j].w); }
        const float rstd = rsqrtf(wave_sum(s) * (1.0f / DM) + EPS);
#pragma unroll
        for (int j = 0; j < 8; ++j) xr[64 * j] = v[j] * rstd * nf[64 * j]; }
}

#define XB_TMO      128
#define XB_XCNT(j)  (256  + 64 * (j))
#define XB_XSUB(j)  (1280 + 64 * (j))
#define XB_XGEN(j)  (2304 + 64 * (j))
#define XB_TOP      3328
#define XB_TOPGEN   3392
#define XCD_BAR_WORDS 3456
#define XB_SPIN_CAP (1u << 18)

__device__ __forceinline__ unsigned xb_ld(unsigned* p)              { return __hip_atomic_load(p, __ATOMIC_RELAXED, __HIP_MEMORY_SCOPE_AGENT); }
__device__ __forceinline__ unsigned xb_add(unsigned* p, unsigned v) { return __hip_atomic_fetch_add(p, v, __ATOMIC_RELAXED, __HIP_MEMORY_SCOPE_AGENT); }
__device__ __forceinline__ unsigned xb_xcc_id() { return (unsigned)__builtin_amdgcn_s_getreg((3 << 11) | 20) & 0xFu; }
#define XB_SPIN(cond, bar) do { unsigned _sp = 0; while (cond) { __builtin_amdgcn_s_sleep(1); \
    if ((++_sp & 255u) == 0u) { if (xb_ld(&(bar)[XB_TMO])) break; if (_sp > XB_SPIN_CAP) { atomicAdd(&(bar)[XB_TMO], 1u); break; } } } } while (0)

struct XcdBarrier {
    unsigned* bar; unsigned x;
    volatile LAS unsigned* st;
};

__device__ __forceinline__ XcdBarrier xcd_barrier_post(unsigned* bar, volatile LAS unsigned* st) {
    XcdBarrier b; b.bar = bar; b.x = xb_xcc_id(); b.st = st;
    if (threadIdx.x == 0) (void)xb_add(&bar[XB_XCNT(b.x)], 1u);
    return b;
}
__device__ __forceinline__ void xcd_barrier_complete(unsigned* bar, unsigned x, unsigned& nloc, unsigned& nx) {
    const unsigned G = gridDim.x * gridDim.y * gridDim.z;
    unsigned sum, cnt, mine, sp = 0u;
    for (;;) {
        sum = 0u; cnt = 0u; mine = 0u;
#pragma unroll
        for (unsigned j = 0; j < 16; ++j) { const unsigned c = xb_ld(&bar[XB_XCNT(j)]); sum += c; cnt += (c > 0u) ? 1u : 0u; mine = (j == x) ? c : mine; }
        if (sum == G) break;
        __builtin_amdgcn_s_sleep(1);
        if ((++sp & 255u) == 0u) { if (xb_ld(&bar[XB_TMO])) break; if (sp > XB_SPIN_CAP) { atomicAdd(&bar[XB_TMO], 1u); break; } }
    }
    nloc = mine > 0u ? mine : 1u; nx = cnt > 0u ? cnt : 1u;
}

__device__ __forceinline__ void xcd_barrier(const XcdBarrier& b) {
    asm volatile("s_waitcnt vmcnt(0)" ::: "memory");
    __syncthreads();
    if (threadIdx.x == 0) {
        unsigned* bar = b.bar;
        __builtin_amdgcn_s_waitcnt(0);
        unsigned nloc = b.st[0], nx = b.st[1];
        if (nloc == 0u) { xcd_barrier_complete(bar, b.x, nloc, nx); b.st[0] = nloc; b.st[1] = nx; }
        const unsigned old = xb_add(&bar[XB_XSUB(b.x)], 1u);
        const unsigned gen = old / nloc;
        if (old + 1u == (gen + 1u) * nloc) {
            __builtin_amdgcn_fence(__ATOMIC_RELEASE, "agent");
            asm volatile("s_waitcnt vmcnt(0)" ::: "memory");
            const unsigned og = xb_add(&bar[XB_TOP], 1u);
            const unsigned tg = og / nx;
            if (og + 1u == (tg + 1u) * nx) xb_add(&bar[XB_TOPGEN], 1u);
            else XB_SPIN(xb_ld(&bar[XB_TOPGEN]) == tg, bar);
            __builtin_amdgcn_fence(__ATOMIC_ACQUIRE, "agent");
            xb_add(&bar[XB_XGEN(b.x)], 1u);
            asm volatile("s_waitcnt vmcnt(0)" ::: "memory");
        } else {
            XB_SPIN(xb_ld(&bar[XB_XGEN(b.x)]) == gen, bar);
            __builtin_amdgcn_fence(__ATOMIC_ACQUIRE, "agent");
            asm volatile("s_waitcnt vmcnt(0)" ::: "memory");
        }
    }
    __syncthreads();
}

__global__ void __launch_bounds__(NTHREADS, 2) fwd_megakernel(Params p) {
    extern __shared__ __attribute__((aligned(16))) unsigned char lds[];
    cg::grid_group grid = cg::this_grid();
    const int tid = threadIdx.x, lane = tid & 63, wave = __builtin_amdgcn_readfirstlane(tid >> 6);
    unsigned char* ws = p.ws; unsigned* ctl = (unsigned*)(ws + WS_CTL);
    volatile int* qslot = (volatile int*)(lds + LDS_BYTES - 64);
    LAS unsigned char* lds3 = (LAS unsigned char*)lds;
    if (p.ws == nullptr) grid.sync();
    volatile LAS unsigned* MISC = (volatile LAS unsigned*)(lds3 + LDS_BYTES - 128);
    if (tid < 16) MISC[tid] = 0u;
    __syncthreads();
    XcdBarrier bar = xcd_barrier_post(ctl + CW_BAR, MISC + 8);
#ifdef TPROBE
    unsigned long long tstamp[12]; int nst = 0;
#define STAMP() do { tstamp[nst++] = __builtin_amdgcn_s_memrealtime(); } while (0)
    STAMP();
#else
#define STAMP() do {} while (0)
#endif
#define GSYNC() do { xcd_barrier(bar); STAMP(); } while (0)

#ifndef SKIP_P0
    p0_prologue(p, lds, tid, lane, wave);
#endif
    GSYNC();
#ifndef SKIP_P1
    p1_norm1(p, lds, tid, lane, wave);
#endif
    GSYNC();
#ifndef SKIP_G2
    { pg8::Gemm g{(const bf16_t*)(ws + WS_H), (const bf16_t*)(ws + WS_WIN), NTOK, PW, DM}; pg8::StaticOrder S; S.init(NTOK, PW, (int)gridDim.x, (int)blockIdx.x);
      pg8::EpiBf16<0> E{(bf16_t*)(ws + WS_P), PW, nullptr, 0, 0, 1.f};
      pg8::gemm_phase<pg8::EpiBf16<0>, pg8::StaticOrder, true, true>(lds3, g, S, E); }
#endif
    GSYNC();
#ifndef SKIP_GLA
    for (int gi = blockIdx.x; gi < 16; gi += gridDim.x) gla_unit(p, lds, gi >> 2, gi & 3, tid, lane, wave);
#endif
    for (;;) { const int it = fetch_item(ctl + CW_Q3, qslot, tid); if (it >= 256 + 512) break;
#ifndef SKIP_CMP
        if (it < 256) nsa_compress_unit(p, lds, it, tid, lane, wave); else
#endif
#ifndef SKIP_WIN
        { const int u = it - 256; const int qblk = 31 - (u >> 4), bg = u & 15; nsa_window_unit(p, lds, bg >> 2, bg & 3, qblk, tid, lane, wave); }
#endif
        ; }
    GSYNC();
    for (;;) { const int it = fetch_item(ctl + CW_Q4, qslot, tid); if (it >= 512) break;
#ifndef SKIP_SEL
        const int qblk = 31 - (it >> 4), bg = it & 15; nsa_cmp_sel_unit(p, lds, bg >> 2, bg & 3, qblk, tid, lane, wave);
#endif
        }
    GSYNC();
#ifndef SKIP_G5
    { pg8::Gemm g{(const bf16_t*)(ws + WS_H), (const bf16_t*)(ws + WS_WOUT), NTOK, DM, DM}; pg8::StaticOrder S; S.init(NTOK, DM, (int)gridDim.x, (int)blockIdx.x);
      pg8::EpiResid E{p.in[0], p.out, (const float*)(ws + WS_MODF) + 4096};
      pg8::gemm_phase<pg8::EpiResid, pg8::StaticOrder, true, true>(lds3, g, S, E); }
#endif
    GSYNC();
#ifndef SKIP_P6
    p6_norm2_route(p, lds, tid, lane, wave);
#endif
    GSYNC();
#ifndef SKIP_P7
    p7_dispatch(p, lds, tid, lane, wave);
#endif
    GSYNC();
    const int nrb = __hip_atomic_load((const int*)(ws + WS_RBE) + 128, __ATOMIC_RELAXED, __HIP_MEMORY_SCOPE_AGENT);
#ifndef SKIP_G8
    { pg8::Gemm g{(const bf16_t*)(ws + WS_P), (const bf16_t*)(ws + WS_WGU), CAP, 32 * 1024, DM}; pg8::GroupedOrder S{(const int*)(ws + WS_RBE), nrb * 4, 4, (int)gridDim.x, (int)blockIdx.x};
      pg8::EpiSwiGLU E{(bf16_t*)(ws + WS_HMID)};
      pg8::gemm_phase<pg8::EpiSwiGLU, pg8::GroupedOrder, true, true>(lds3, g, S, E); }
#endif
    GSYNC();
#ifndef SKIP_G9
    { pg8::Gemm g{(const bf16_t*)(ws + WS_HMID), (const bf16_t*)(ws + WS_WD), CAP, 32 * 2048, 512}; pg8::GroupedOrder S{(const int*)(ws + WS_RBE), nrb * 8, 8, (int)gridDim.x, (int)blockIdx.x};
      pg8::EpiDown E{(bf16_t*)(ws + WS_P), (const int*)(ws + WS_SLOTT), (const float*)(ws + WS_SLOTW)};
      pg8::gemm_phase<pg8::EpiDown, pg8::GroupedOrder, true, true>(lds3, g, S, E); }
#endif
    GSYNC();
#ifndef SKIP_P10
    p10_final(p, tid, lane, wave);
#endif
#ifdef TPROBE
    STAMP();
    if (blockIdx.x == 0 && tid == 0) { const float us = (float)(tstamp[TPROBE + 1] - tstamp[TPROBE]) * 0.01f; p.out[0] = us * 0.1f; }
#endif
}

extern "C" void kernel_launch(void* const* d_in, const int* in_sizes, int n_in, void* d_out, int out_size, void* d_ws, size_t ws_size, hipStream_t stream) {
    static int grid_blocks = 0;
    if (!grid_blocks) {
        int dev = 0, cus = 0, per_cu = 0;
        (void)hipGetDevice(&dev);
        (void)hipDeviceGetAttribute(&cus, hipDeviceAttributeMultiprocessorCount, dev);
        (void)hipFuncSetAttribute((const void*)fwd_megakernel, hipFuncAttributeMaxDynamicSharedMemorySize, LDS_BYTES);
        (void)hipOccupancyMaxActiveBlocksPerMultiprocessor(&per_cu, (const void*)fwd_megakernel, NTHREADS, LDS_BYTES);
        if (per_cu < 1) fprintf(stderr, "kernel_launch: occupancy query reports %d blocks/CU\n", per_cu);
        grid_blocks = cus;
        if (ws_size < WS_END || n_in != 25) { fprintf(stderr, "kernel_launch: ws %zu < %zu or n_in %d != 25\n", ws_size, (size_t)WS_END, n_in); }
    }
    (void)hipMemsetAsync((char*)d_ws + WS_CTL, 0, CTL_ZERO_BYTES, stream);
    Params p{};
    for (int i = 0; i < 25; ++i) p.in[i] = (const float*)d_in[i];
    p.out = (float*)d_out; p.ws = (unsigned char*)d_ws;
    void* args[] = {&p};
    hipError_t e = hipLaunchCooperativeKernel((void*)fwd_megakernel, dim3(grid_blocks), dim3(NTHREADS), args, LDS_BYTES, stream);
    if (e != hipSuccess) fprintf(stderr, "cooperative launch failed: %s (grid %d)\n", hipGetErrorString(e), grid_blocks);
}
```

```cpp
#include <hip/hip_runtime.h>
#include <hip/hip_cooperative_groups.h>
#include <cstdio>
#include <cstdint>
namespace cg = cooperative_groups;
namespace pg8 {
#define PG8_LAS __attribute__((address_space(3)))
typedef unsigned short bf16_t;
typedef short bf16x8 __attribute__((ext_vector_type(8)));
typedef float f32x4 __attribute__((ext_vector_type(4)));
typedef unsigned u32x4 __attribute__((ext_vector_type(4)));
constexpr int BM = 256, BK = 64, HALF = 128, HTB = HALF * BK * 2  , STAGE_BYTES = 8 * HTB, NXCD = 8, WGM = 8;

__host__ __device__ __forceinline__ int lds_byte(int r, int c) { const int st = (r >> 4) * 2 + (c >> 5), rr = r & 15, cc = c & 31, ob = rr * 64 + cc * 2; return st * 1024 + (ob ^ (((ob >> 9) & 1) << 5)); }
__host__ __device__ __forceinline__ void stage_rc(int b, int& R, int& C) { const int st = b / 1024, sb = b % 1024, swz = sb ^ (((sb >> 9) & 1) << 5); R = (st >> 1) * 16 + swz / 64; C = (st & 1) * 32 + (swz % 64) / 2; }
__host__ __device__ __forceinline__ int perm32(int rho) { const int n = rho >> 4, i = rho & 15; return 8 * (i >> 2) + 4 * n + (i & 3); }

struct Unit { int pm, pn; };
struct Gemm { const bf16_t* A; const bf16_t* Bt; int M, N, K; };

struct StaticOrder {
    int nM, nN, nwg, G, c;
    __host__ __device__ void init(int M, int N, int G_, int c_) { nM = M / BM; nN = N / BM; nwg = nM * nN; G = G_; c = c_; }
    __host__ __device__ bool next(int i, Unit& u) const {
        const long L = (long)i * G + c; if (L >= nwg) return false;
        int wgid = (int)L; { const int q = nwg / NXCD, r = nwg % NXCD, xcd = wgid % NXCD, off = wgid / NXCD; wgid = (xcd < r ? xcd * (q + 1) : r * (q + 1) + (xcd - r) * q) + off; }
        const int nig = WGM * nN, gid = wgid / nig, fm = gid * WGM, gsz = (nM - fm) < WGM ? (nM - fm) : WGM;
        u.pm = fm + ((wgid % nig) % gsz); u.pn = (wgid % nig) / gsz; return true;
    }
    __device__ __forceinline__ void a_ready(const Unit&) const {}
    __device__ __forceinline__ void done(const Unit&) const {}
};

__device__ __forceinline__ unsigned cvt_pk_bf16(float lo, float hi) { unsigned r; asm volatile("v_cvt_pk_bf16_f32 %0, %1, %2" : "=v"(r) : "v"(lo), "v"(hi)); return r; }
typedef float f32x2 __attribute__((ext_vector_type(2)));
__device__ __forceinline__ f32x2 gelu_pk(f32x2 v) {
    const f32x2 av = __builtin_elementwise_abs(v), d = av * 0.2316418882f + 1.0f;
    f32x2 t; t.x = __builtin_amdgcn_rcpf(d.x); t.y = __builtin_amdgcn_rcpf(d.y);
    f32x2 q = t * 0.5307027145f + (-0.7265760135f); q = q * t + 0.7107068705f; q = q * t + (-0.142248368f); q = q * t + 0.127414796f; q = q * t;
    const f32x2 s = (v * v) * (-0.72134752044f);
    f32x2 e; e.x = __builtin_amdgcn_exp2f(s.x); e.y = __builtin_amdgcn_exp2f(s.y);
    const f32x2 m = v * (q * e), r = v - m;
    f32x2 o; o.x = v.x < 0.f ? m.x : r.x; o.y = v.y < 0.f ? m.y : r.y; return o;
}

template <int ACT  > struct EpiBf16 {
    static constexpr bool PERM = true, AFTER_DRAIN = false; static_assert(ACT == 0 || ACT == 1, "EpiBf16: ACT is 0 (none) or 1 (gelu_pk)");
    bf16_t* O; int ldc; const float* bias; int split_cols; size_t split_stride; float scale0;
    __device__ __forceinline__ void operator()(const f32x4 (&acc)[2][2][4][2], const Unit& u, int wr, int wc, int fr, int fq) const {
        const int row0 = u.pm * BM + wr * 64 + fr; int colt = u.pn * BM; bf16_t* base = O;
        float sc = 1.f; if (split_cols) { const int t = colt / split_cols; base += (size_t)t * split_stride; colt -= t * split_cols; if (t == 0) sc = scale0; }
        const int col0 = colt + wc * 32 + 8 * fq, bcol0 = u.pn * BM + wc * 32 + 8 * fq;
        f32x4 bv[2][2];
#pragma unroll
        for (int bj = 0; bj < 2; ++bj)
#pragma unroll
            for (int n = 0; n < 2; ++n) bv[bj][n] = bias ? *(const f32x4*)(bias + bcol0 + bj * HALF + 4 * n) : (f32x4){0.f, 0.f, 0.f, 0.f};
#pragma unroll
        for (int ai = 0; ai < 2; ++ai)
#pragma unroll
            for (int m = 0; m < 4; ++m) { bf16_t* rowp = base + (size_t)(row0 + ai * HALF + m * 16) * ldc + col0;
#pragma unroll
                for (int bj = 0; bj < 2; ++bj) { f32x4 v0 = acc[ai][bj][m][0] + bv[bj][0], v1 = acc[ai][bj][m][1] + bv[bj][1];
                    if (ACT == 1) { f32x2 a = gelu_pk((f32x2){v0[0], v0[1]}), b = gelu_pk((f32x2){v0[2], v0[3]}), c = gelu_pk((f32x2){v1[0], v1[1]}), d = gelu_pk((f32x2){v1[2], v1[3]});
                        v0 = (f32x4){a.x, a.y, b.x, b.y}; v1 = (f32x4){c.x, c.y, d.x, d.y}; }
                    v0 = v0 * sc; v1 = v1 * sc; u32x4 w; w.x = cvt_pk_bf16(v0[0], v0[1]); w.y = cvt_pk_bf16(v0[2], v0[3]); w.z = cvt_pk_bf16(v1[0], v1[1]); w.w = cvt_pk_bf16(v1[2], v1[3]);
                    *(u32x4*)(rowp + bj * HALF) = w; } }
    }
};
template <class Epi, class Sched, bool ALIGN_EPI = false, bool SP2 = false>
__device__ __forceinline__ void gemm_phase(PG8_LAS unsigned char* lds, const Gemm g, const Sched& S, const Epi& E) {
    int tid_ = threadIdx.x; asm volatile("" : "+v"(tid_));
    const int tid = tid_, wid = __builtin_amdgcn_readfirstlane(tid >> 6), lane = tid & 63, wr = wid >> 2, wc = wid & 3, fr = lane & 15, fq = lane >> 4;
    const int K = g.K, nt = K / BK;
    unsigned voffA[2], voffB[2];
#pragma unroll
    for (int i = 0; i < 2; ++i) { int R, C; stage_rc(tid * 16 + i * 8192, R, C); const int Rb = Epi::PERM ? ((R & ~31) + perm32(R & 31)) : R;
        voffA[i] = (unsigned)(R * K + C) * 2u; voffB[i] = (unsigned)(Rb * K + C) * 2u; }
    const size_t kstep = (size_t)(BK * 2);
    const size_t hstep = (size_t)HALF * K * 2;
    const size_t tstep = 2 * hstep;
    const unsigned ldsw = (unsigned)wid * 1024u;
    const int aoff = lds_byte(wr * 64 + fr, fq * 8), boff = lds_byte(wc * 32 + fr, fq * 8);
#define PG8_SA(b, h) (((b) * 2 + (h)) * HTB)
#define PG8_SB(b, h) ((4 + (b) * 2 + (h)) * HTB)
#define PG8_STAGE(bufoff, gbase, voff) do { _Pragma("unroll") for (int _i = 0; _i < 2; ++_i) \
        __builtin_amdgcn_global_load_lds((const unsigned*)((const char*)(gbase) + (voff)[_i]), (PG8_LAS unsigned*)(lds + (bufoff) + ldsw + _i * 8192), 16, 0, 0); } while (0)
#define PG8_LDA(dst, b, h) do { _Pragma("unroll") for (int m = 0; m < 4; ++m) _Pragma("unroll") for (int k = 0; k < 2; ++k) dst[m][k] = *(const PG8_LAS bf16x8*)(lds + PG8_SA(b, h) + aoff + m * 2048 + k * 1024); } while (0)
#define PG8_LDB(dst, b, h) do { _Pragma("unroll") for (int n = 0; n < 2; ++n) _Pragma("unroll") for (int k = 0; k < 2; ++k) dst[n][k] = *(const PG8_LAS bf16x8*)(lds + PG8_SB(b, h) + boff + n * 2048 + k * 1024); } while (0)
#define PG8_MMA(ai, bj, At, Bt) do { __builtin_amdgcn_s_setprio(1); _Pragma("unroll") for (int m = 0; m < 4; ++m) _Pragma("unroll") for (int n = 0; n < 2; ++n) _Pragma("unroll") for (int k = 0; k < 2; ++k) \
        acc[ai][bj][m][n] = __builtin_amdgcn_mfma_f32_16x16x32_bf16(Bt[n][k], At[m][k], acc[ai][bj][m][n], 0, 0, 0); __builtin_amdgcn_s_setprio(0); } while (0)
#define PG8_WAIT_V(n) asm volatile("s_waitcnt vmcnt(" #n ")" ::: "memory")
#define PG8_WAIT_L(n) asm volatile("s_waitcnt lgkmcnt(" #n ")" ::: "memory")
#define PG8_BAR __builtin_amdgcn_s_barrier()
#define PG8_SCHED __builtin_amdgcn_sched_barrier(0)
    Unit cur, nxt; int ui = 0;
    if (!S.next(0, cur)) return;
    f32x4 acc[2][2][4][2];
#pragma unroll
    for (int a = 0; a < 2; ++a)
#pragma unroll
        for (int b = 0; b < 2; ++b)
#pragma unroll
            for (int m = 0; m < 4; ++m)
#pragma unroll
                for (int n = 0; n < 2; ++n) acc[a][b][m][n] = (f32x4){0.f, 0.f, 0.f, 0.f};
    bf16x8 At[4][2], B0[2][2], B1[2][2];
    const char* cA = (const char*)g.A + (size_t)cur.pm * tstep; const char* cB = (const char*)g.Bt + (size_t)cur.pn * tstep;
    S.a_ready(cur);
    if constexpr (SP2) {
        PG8_STAGE(PG8_SB(0, 0), cB, voffB); PG8_STAGE(PG8_SB(0, 1), cB + hstep, voffB); PG8_STAGE(PG8_SA(0, 0), cA, voffA); PG8_STAGE(PG8_SA(0, 1), cA + hstep, voffA);
        if (wr == 1) PG8_BAR;
        PG8_WAIT_V(2); PG8_BAR;
        PG8_STAGE(PG8_SB(1, 0), cB + kstep, voffB); PG8_STAGE(PG8_SA(1, 0), cA + kstep, voffA); PG8_STAGE(PG8_SB(1, 1), cB + hstep + kstep, voffB);
        PG8_WAIT_V(6); PG8_BAR;
    } else {
        PG8_STAGE(PG8_SB(0, 0), cB, voffB); PG8_STAGE(PG8_SA(0, 0), cA, voffA); PG8_STAGE(PG8_SB(0, 1), cB + hstep, voffB); PG8_STAGE(PG8_SA(0, 1), cA + hstep, voffA);
        if (wr == 1) PG8_BAR;
        PG8_WAIT_V(4); PG8_BAR;
        PG8_STAGE(PG8_SB(1, 0), cB + kstep, voffB); PG8_STAGE(PG8_SA(1, 0), cA + kstep, voffA); PG8_STAGE(PG8_SB(1, 1), cB + hstep + kstep, voffB);
        PG8_WAIT_V(6); PG8_BAR;
    }
    for (;;) {
        const bool has_next = S.next(ui + 1, nxt);
        const char* nA = has_next ? (const char*)g.A + (size_t)nxt.pm * tstep : cA; const char* nB = has_next ? (const char*)g.Bt + (size_t)nxt.pn * tstep : cB;
        for (int t = 0; t < nt; t += 2) {
            const bool last = (t == nt - 2);
            const char* a1 = cA + (size_t)(t + 1) * kstep;
            const char* a2 = last ? nA : cA + (size_t)(t + 2) * kstep; const char* b2 = last ? nB : cB + (size_t)(t + 2) * kstep;
            const char* a3 = a2 + kstep; const char* b3 = b2 + kstep;
            if (last && has_next) S.a_ready(nxt);
            if constexpr (SP2) {
            PG8_LDB(B0, 0, 0); PG8_LDB(B1, 0, 1); PG8_SCHED; PG8_LDA(At, 0, 0); PG8_STAGE(PG8_SA(1, 1), a1 + hstep, voffA);
            PG8_WAIT_V(8); PG8_WAIT_L(0); PG8_BAR; PG8_MMA(0, 0, At, B0); PG8_MMA(0, 1, At, B1); PG8_BAR; PG8_SCHED;
            PG8_LDA(At, 0, 1); PG8_STAGE(PG8_SB(0, 0), b2, voffB); PG8_STAGE(PG8_SB(0, 1), b2 + hstep, voffB); PG8_STAGE(PG8_SA(0, 0), a2, voffA);
            PG8_WAIT_V(8); PG8_WAIT_L(0); PG8_BAR; PG8_MMA(1, 0, At, B0); PG8_MMA(1, 1, At, B1); PG8_BAR; PG8_SCHED;
            PG8_LDB(B0, 1, 0); PG8_LDB(B1, 1, 1); PG8_SCHED; PG8_LDA(At, 1, 0); PG8_STAGE(PG8_SA(0, 1), a2 + hstep, voffA);
            PG8_WAIT_V(8); PG8_WAIT_L(0); PG8_BAR; PG8_MMA(0, 0, At, B0); PG8_MMA(0, 1, At, B1); PG8_BAR; PG8_SCHED;
            PG8_LDA(At, 1, 1); PG8_STAGE(PG8_SB(1, 0), b3, voffB); PG8_STAGE(PG8_SB(1, 1), b3 + hstep, voffB); PG8_STAGE(PG8_SA(1, 0), a3, voffA);
            PG8_WAIT_V(8); PG8_WAIT_L(0); PG8_BAR; PG8_MMA(1, 0, At, B0); PG8_MMA(1, 1, At, B1); PG8_BAR; PG8_SCHED;
            } else {
            PG8_LDB(B0, 0, 0); PG8_SCHED; PG8_LDA(At, 0, 0); PG8_STAGE(PG8_SA(1, 1), a1 + hstep, voffA);
            PG8_WAIT_L(8); PG8_BAR; PG8_WAIT_L(0); PG8_MMA(0, 0, At, B0); PG8_BAR; PG8_SCHED;
            PG8_LDB(B1, 0, 1); PG8_STAGE(PG8_SB(0, 0), b2, voffB);
            PG8_BAR; PG8_WAIT_L(0); PG8_MMA(0, 1, At, B1); PG8_BAR;
            PG8_LDA(At, 0, 1); PG8_STAGE(PG8_SA(0, 0), a2, voffA);
            PG8_BAR; PG8_WAIT_L(0); PG8_MMA(1, 0, At, B0); PG8_BAR; PG8_SCHED;
            PG8_STAGE(PG8_SB(0, 1), b2 + hstep, voffB);
            PG8_WAIT_V(6); PG8_BAR; PG8_MMA(1, 1, At, B1); PG8_BAR;
            PG8_LDB(B0, 1, 0); PG8_SCHED; PG8_LDA(At, 1, 0); PG8_STAGE(PG8_SA(0, 1), a2 + hstep, voffA);
            PG8_WAIT_L(8); PG8_BAR; PG8_WAIT_L(0); PG8_MMA(0, 0, At, B0); PG8_BAR; PG8_SCHED;
            PG8_LDB(B1, 1, 1); PG8_STAGE(PG8_SB(1, 0), b3, voffB);
            PG8_BAR; PG8_WAIT_L(0); PG8_MMA(0, 1, At, B1); PG8_BAR;
            PG8_LDA(At, 1, 1); PG8_STAGE(PG8_SA(1, 0), a3, voffA);
            PG8_BAR; PG8_WAIT_L(0); PG8_MMA(1, 0, At, B0); PG8_BAR; PG8_SCHED;
            PG8_STAGE(PG8_SB(1, 1), b3 + hstep, voffB);
            PG8_WAIT_V(6); PG8_BAR; PG8_MMA(1, 1, At, B1); PG8_BAR;
            }
        }
        if constexpr (ALIGN_EPI) { if (wr == 0) PG8_BAR; }
        if constexpr (!Epi::AFTER_DRAIN) { E(acc, cur, wr, wc, fr, fq); S.done(cur); }
        if (!has_next) break;
#pragma unroll
        for (int a = 0; a < 2; ++a)
#pragma unroll
            for (int b = 0; b < 2; ++b)
#pragma unroll
                for (int m = 0; m < 4; ++m)
#pragma unroll
                    for (int n = 0; n < 2; ++n) acc[a][b][m][n] = (f32x4){0.f, 0.f, 0.f, 0.f};
        cur = nxt; cA = nA; cB = nB; ++ui;
        if constexpr (ALIGN_EPI) { if (wr == 1) PG8_BAR; }
    }
    PG8_WAIT_V(0);
    if constexpr (!ALIGN_EPI) { if (wr == 0) PG8_BAR; }
    PG8_BAR;
    if constexpr (Epi::AFTER_DRAIN) { E.fused(acc, cur, wr, wc, fr, fq, lds, wid, lane); S.done(cur); }
#undef PG8_SA
#undef PG8_SB
#undef PG8_STAGE
#undef PG8_LDA
#undef PG8_LDB
#undef PG8_MMA
#undef PG8_WAIT_V
#undef PG8_WAIT_L
#undef PG8_BAR
#undef PG8_SCHED
}
}

namespace pg8 {
__device__ __forceinline__ float silu_f(float x) { return x * __builtin_amdgcn_rcpf(1.0f + __builtin_amdgcn_exp2f(-1.4426950408889634f * x)); }
struct EpiResid {
    static constexpr bool PERM = true, AFTER_DRAIN = false;
    const float* X; float* O; const float* G;
    __device__ __forceinline__ void operator()(const f32x4 (&acc)[2][2][4][2], const Unit& u, int wr, int wc, int fr, int fq) const {
        const int row0 = u.pm * BM + wr * 64 + fr, col0 = u.pn * BM + wc * 32 + 8 * fq;
        const int b = (u.pm * BM) >> 11;
        const float* gp = G + (size_t)b * 12288 + col0;
        f32x4 gv[2][2];
#pragma unroll
        for (int bj = 0; bj < 2; ++bj)
#pragma unroll
            for (int n = 0; n < 2; ++n) gv[bj][n] = *(const f32x4*)(gp + bj * HALF + 4 * n);
#pragma unroll
        for (int ai = 0; ai < 2; ++ai)
#pragma unroll
            for (int m = 0; m < 4; ++m) { const size_t off = (size_t)(row0 + ai * HALF + m * 16) * 2048 + col0;
#pragma unroll
                for (int bj = 0; bj < 2; ++bj)
#pragma unroll
                    for (int n = 0; n < 2; ++n) { const f32x4 xv = *(const f32x4*)(X + off + bj * HALF + 4 * n); const f32x4 o = xv + gv[bj][n] * acc[ai][bj][m][n]; *(f32x4*)(O + off + bj * HALF + 4 * n) = o; } }
    }
};
struct EpiSwiGLU {
    static constexpr bool PERM = true, AFTER_DRAIN = false;
    bf16_t* Hm;
    __device__ __forceinline__ void operator()(const f32x4 (&acc)[2][2][4][2], const Unit& u, int wr, int wc, int fr, int fq) const {
        const int t = u.pn & 3; const int row0 = u.pm * BM + wr * 64 + fr, col0 = t * 128 + wc * 32 + 8 * fq;
#pragma unroll
        for (int ai = 0; ai < 2; ++ai)
#pragma unroll
            for (int m = 0; m < 4; ++m) { bf16_t* rowp = Hm + (size_t)(row0 + ai * HALF + m * 16) * 512 + col0;
                const f32x4 g0 = acc[ai][0][m][0], g1 = acc[ai][0][m][1], u0 = acc[ai][1][m][0], u1 = acc[ai][1][m][1];
                u32x4 w; w.x = cvt_pk_bf16(silu_f(g0[0]) * u0[0], silu_f(g0[1]) * u0[1]); w.y = cvt_pk_bf16(silu_f(g0[2]) * u0[2], silu_f(g0[3]) * u0[3]);
                w.z = cvt_pk_bf16(silu_f(g1[0]) * u1[0], silu_f(g1[1]) * u1[1]); w.w = cvt_pk_bf16(silu_f(g1[2]) * u1[2], silu_f(g1[3]) * u1[3]);
                *(u32x4*)rowp = w; }
    }
};
struct EpiDown {
    static constexpr bool PERM = true, AFTER_DRAIN = false;
    bf16_t* Y; const int* slot_tok; const float* slot_w;
    __device__ __forceinline__ void operator()(const f32x4 (&acc)[2][2][4][2], const Unit& u, int wr, int wc, int fr, int fq) const {
        const int t = u.pn & 7; const int row0 = u.pm * BM + wr * 64 + fr, col0 = t * 256 + wc * 32 + 8 * fq;
#pragma unroll
        for (int ai = 0; ai < 2; ++ai)
#pragma unroll
            for (int m = 0; m < 4; ++m) { const int slot = row0 + ai * HALF + m * 16; const int st = slot_tok[slot];
                if (st >= 0) { const float w = slot_w[slot]; bf16_t* rowp = Y + (size_t)st * 2048 + col0;
#pragma unroll
                    for (int bj = 0; bj < 2; ++bj) { const f32x4 v0 = acc[ai][bj][m][0] * w, v1 = acc[ai][bj][m][1] * w;
                        u32x4 o; o.x = cvt_pk_bf16(v0[0], v0[1]); o.y = cvt_pk_bf16(v0[2], v0[3]); o.z = cvt_pk_bf16(v1[0], v1[1]); o.w = cvt_pk_bf16(v1[2], v1[3]);
                        *(u32x4*)(rowp + bj * HALF) = o; } } }
    }
};
struct GroupedOrder {
    const int* rbe; int nunits, NT, G, c;
    __device__ __forceinline__ bool next(int i, Unit& u) const {
        const long L = (long)i * G + c; if (L >= nunits) return false;
        const int rb = (int)(L / NT), t = (int)(L % NT);
        const int e = __hip_atomic_load(rbe + rb, __ATOMIC_RELAXED, __HIP_MEMORY_SCOPE_AGENT);
        u.pm = rb; u.pn = e * NT + t; return true;
    }
    __device__ __forceinline__ void a_ready(const Unit&) const {}
    __device__ __forceinline__ void done(const Unit&) const {}
};
}

using pg8::bf16_t; using pg8::bf16x8; using pg8::f32x4; using pg8::u32x4;
typedef float f32x16 __attribute__((ext_vector_type(16)));
typedef short s16x4 __attribute__((ext_vector_type(4)));
typedef unsigned u32x2 __attribute__((ext_vector_type(2)));
#define LAS __attribute__((address_space(3)))

constexpr int NTHREADS = 512, NWAVES = 8;
constexpr int LDS_BYTES = 147456;
constexpr int DM = 2048, NTOK = 8192, SEQ = 2048, NB = 4;
constexpr int PW = 5888;
constexpr int PC_Q = 0, PC_KC = 1024, PC_VC = 1280, PC_KS = 1536, PC_VS = 1792, PC_KW = 2048, PC_VW = 2304;
constexpr int PC_GQ = 2560, PC_GK = 3072, PC_GV = 3584, PC_GO = 4608, PC_GATE = 5632, PC_LR = 5680;
constexpr int NKC = 16;
constexpr int CAP = 24576;
constexpr float LOG2E = 1.4426950408889634f;
constexpr float EPS = 1e-6f;

constexpr size_t MiB = 1u << 20;
constexpr size_t WS_CTL = 0, CTL_ZERO_BYTES = 64 * 1024;
constexpr size_t WS_MODP = 1 * MiB;
constexpr size_t WS_MODF = 5 * MiB;
constexpr size_t WS_A2G = WS_MODF + 256 * 1024;
constexpr size_t WS_SH2G = WS_A2G + 64 * 1024;
constexpr size_t WS_SMALL = 6 * MiB;
constexpr size_t WS_W1TK = WS_SMALL;
constexpr size_t WS_W1TV = WS_W1TK + 256 * 1024;
constexpr size_t WS_W2TK = WS_W1TV + 256 * 1024;
constexpr size_t WS_W2TV = WS_W2TK + 8 * 1024;
constexpr size_t WS_POSW1 = WS_W2TV + 8 * 1024;
constexpr size_t WS_KC = WS_POSW1 + 4 * 1024;
constexpr size_t WS_VCT = WS_KC + 256 * 1024;
constexpr size_t WS_WRH = WS_VCT + 256 * 1024;
constexpr size_t WS_WRL = WS_WRH + 192 * 1024;
constexpr size_t WS_ROUTE = 8 * MiB;
constexpr size_t WS_TOKE = WS_ROUTE;
constexpr size_t WS_TOKW = WS_TOKE + 64 * 1024;
constexpr size_t WS_TOKP = WS_TOKW + 64 * 1024;
constexpr size_t WS_SLOTT = WS_TOKP + 64 * 1024;
constexpr size_t WS_SLOTW = WS_SLOTT + 128 * 1024;
constexpr size_t WS_RBE = WS_SLOTW + 128 * 1024;
constexpr size_t WS_WIN = 10 * MiB;
constexpr size_t WS_WOUT = 33 * MiB;
constexpr size_t WS_WGU = 41 * MiB;
constexpr size_t WS_WD = 169 * MiB;
constexpr size_t WS_H = 233 * MiB;
constexpr size_t WS_P = 265 * MiB;
constexpr size_t WS_OW = 361 * MiB;
constexpr size_t WS_HMID = 377 * MiB;
constexpr size_t WS_GQT = 401 * MiB;
constexpr size_t WS_GOI = 409 * MiB;
constexpr size_t WS_GDS = 425 * MiB;
constexpr size_t WS_GSS = 457 * MiB;
constexpr size_t WS_GDEC = 489 * MiB;
constexpr size_t WS_END = 490 * MiB;
constexpr int CW_Q3 = 64, CW_Q4 = 128, CW_ECNT = 256, CW_BAR = 4096;

struct Params { const float* in[25]; float* out; unsigned char* ws; };
struct KP { volatile __attribute__((address_space(3))) unsigned long long* tab; float* out; unsigned char* ws;
    __device__ __forceinline__ const float* in(int i) const { const unsigned long long v = tab[i];
        const unsigned lo = __builtin_amdgcn_readfirstlane((unsigned)v), hi = __builtin_amdgcn_readfirstlane((unsigned)(v >> 32));
        return (const float*)(((unsigned long long)hi << 32) | lo); } };

__device__ __forceinline__ float bf2f(unsigned short v) { return __uint_as_float((unsigned)v << 16); }
__device__ __forceinline__ unsigned pk2(float lo, float hi) {
    typedef float f2_t __attribute__((ext_vector_type(2))); typedef __bf16 b2_t __attribute__((ext_vector_type(2)));
    f2_t v = {lo, hi}; b2_t b = __builtin_convertvector(v, b2_t); return __builtin_bit_cast(unsigned, b);
}
__device__ __forceinline__ unsigned short f2bf(float f) { return (unsigned short)(pk2(f, 0.f) & 0xffffu); }
__device__ __forceinline__ float wave_sum(float v) {
#pragma unroll
    for (int o = 1; o < 64; o <<= 1) v += __shfl_xor(v, o);
    return v;
}
__device__ __forceinline__ float fexp2(float x) { return __builtin_amdgcn_exp2f(x); }
__device__ __forceinline__ float fexp(float x) { return __builtin_amdgcn_exp2f(x * LOG2E); }
__device__ __forceinline__ float sigmoid_f(float x) { return __builtin_amdgcn_rcpf(1.0f + fexp(-x)); }
__device__ __forceinline__ f32x16 mfma32(bf16x8 a, bf16x8 b, f32x16 c) { return __builtin_amdgcn_mfma_f32_32x32x16_bf16(a, b, c, 0, 0, 0); }
__device__ __forceinline__ f32x4 mfma16(bf16x8 a, bf16x8 b, f32x4 c) { return __builtin_amdgcn_mfma_f32_16x16x32_bf16(a, b, c, 0, 0, 0); }
__device__ __forceinline__ bf16x8 cat4(s16x4 a, s16x4 b) { return (bf16x8){a[0], a[1], a[2], a[3], b[0], b[1], b[2], b[3]}; }

template <class Map>
__device__ __forceinline__ void tr_item(const float* __restrict__ W, int K, int N, int k0, int n0, bf16_t* WT, const Map& map, float* scr, int lane) {
#pragma unroll 8
    for (int i = 0; i < 32; ++i) { const int kk = 2 * i + (lane >> 5); scr[kk * 33 + (lane & 31)] = W[(size_t)(k0 + kk) * N + n0 + (lane & 31)]; }
    asm volatile("s_waitcnt lgkmcnt(0)" ::: "memory");
    const int c = lane & 7;
#pragma unroll
    for (int j = 0; j < 4; ++j) { const int n = (lane >> 3) + 8 * j; const float* s = scr + (8 * c) * 33 + n; const int row = map(n0 + n);
        u32x4 o; o.x = pk2(s[0 * 33], s[1 * 33]); o.y = pk2(s[2 * 33], s[3 * 33]); o.z = pk2(s[4 * 33], s[5 * 33]); o.w = pk2(s[6 * 33], s[7 * 33]);
        if (row >= 0) *(u32x4*)(WT + (size_t)row * K + k0 + 8 * c) = o; }
    asm volatile("s_waitcnt lgkmcnt(0)" ::: "memory");
}
struct MapIn { __device__ __forceinline__ int operator()(int oc) const {
    if (oc < 2560) return oc; if (oc < 2608) return oc - 2560 + PC_GATE; if (oc < 5680) return oc - 48; return oc; } };
struct MapOff { int off; __device__ __forceinline__ int operator()(int n) const { return off + n; } };
struct MapGU { int base; __device__ __forceinline__ int operator()(int n) const { return base + (n >> 7) * 256 + (n & 127); } };

__device__ __forceinline__ void p0_prologue(const KP& p, unsigned char* lds, int tid, int lane, int wave) {
    const int G = gridDim.x, gw = blockIdx.x * NWAVES + wave, NGW = G * NWAVES;
    unsigned char* ws = p.ws;
    float* scr = (float*)(lds + wave * 8448);
    float* SC = (float*)(lds + 69632);
    for (int i = tid; i < 4 * 2048; i += NTHREADS) { const float v = p.in(1)[i]; SC[i] = v * sigmoid_f(v); }
    __syncthreads();
    constexpr int nGEMV = NKC * 48, nTin = 32 * 178, nTout = 32 * 64, nTg = 32 * 32 * 16, nTd = 32 * 8 * 64, nTc1 = 64, nTc2 = 2, nZero = 192, nPos = 2;
    constexpr int nTotal = nGEMV + nTin + nTout + 2 * nTg + nTd + 2 * nTc1 + 2 * nTc2 + nZero + nPos;
    for (int it = gw; it < nTotal; it += NGW) {
        int r = it;
        if (r < nGEMV) {
            const int cgp = r % 48, kc = r / 48; const int col = cgp * 256 + lane * 4; const float* W = p.in(2) + (size_t)(kc * 128) * 12288 + col;
            f32x4 a0 = {0, 0, 0, 0}, a1 = a0, a2 = a0, a3 = a0;
#pragma unroll 8
            for (int kk = 0; kk < 128; ++kk) { const f32x4 w = *(const f32x4*)(W + (size_t)kk * 12288); const int k = kc * 128 + kk;
                a0 += w * SC[k]; a1 += w * SC[2048 + k]; a2 += w * SC[4096 + k]; a3 += w * SC[6144 + k]; }
            float* mp = (float*)(ws + WS_MODP) + (size_t)kc * 4 * 12288 + col;
            *(f32x4*)(mp) = a0; *(f32x4*)(mp + 12288) = a1; *(f32x4*)(mp + 2 * 12288) = a2; *(f32x4*)(mp + 3 * 12288) = a3;
            continue; }
        r -= nGEMV;
        if (r < nTin) { const int kb = r / 178, nb = r % 178; tr_item(p.in(5), 2048, 5696, 64 * kb, 32 * nb, (bf16_t*)(ws + WS_WIN), MapIn{}, scr, lane); continue; }
        r -= nTin;
        if (r < nTout) { const int kb = r / 64, nb = r % 64; tr_item(p.in(15), 2048, 2048, 64 * kb, 32 * nb, (bf16_t*)(ws + WS_WOUT), MapOff{0}, scr, lane); continue; }
        r -= nTout;
        if (r < 2 * nTg) { const int up = r / nTg; r -= up * nTg; const int e = r / 512, q = r % 512, kb = q / 16, nb = q % 16;
            tr_item(p.in(21 + up) + (size_t)e * 2048 * 512, 2048, 512, 64 * kb, 32 * nb, (bf16_t*)(ws + WS_WGU), MapGU{e * 1024 + up * 128}, scr, lane); continue; }
        r -= 2 * nTg;
        if (r < nTd) { const int e = r / 512, q = r % 512, kb = q / 64, nb = q % 64;
            tr_item(p.in(23) + (size_t)e * 512 * 2048, 512, 2048, 64 * kb, 32 * nb, (bf16_t*)(ws + WS_WD), MapOff{e * 2048}, scr, lane); continue; }
        r -= nTd;
        if (r < 2 * nTc1) { const int v = r / nTc1; r -= v * nTc1; const int kb = r / 2, nb = r % 2;
            tr_item(p.in(v ? 10 : 7), 2048, 64, 64 * kb, 32 * nb, (bf16_t*)(ws + (v ? WS_W1TV : WS_W1TK)), MapOff{0}, scr, lane); continue; }
        r -= 2 * nTc1;
        if (r < 2 * nTc2) { const int v = r / nTc2, nb = r % nTc2;
            tr_item(p.in(v ? 11 : 8), 64, 64, 0, 32 * nb, (bf16_t*)(ws + (v ? WS_W2TV : WS_W2TK)), MapOff{0}, scr, lane); continue; }
        r -= 2 * nTc2;
        if (r < nZero) { u32x4* z = (u32x4*)((bf16_t*)(ws + WS_WIN) + (size_t)(5696 + r) * 2048);
#pragma unroll
            for (int j = 0; j < 4; ++j) z[lane + 64 * j] = (u32x4){0u, 0u, 0u, 0u};
            continue; }
        r -= nZero;
        {
            const int v = r; const float* pos = p.in(v ? 9 : 6); const float* w1 = p.in(v ? 10 : 7); float s = 0.f;
            for (int k = 0; k < 2048; ++k) s += pos[k] * w1[(size_t)k * 64 + lane];
            ((float*)(ws + WS_POSW1))[v * 64 + lane] = s; }
    }
    { bf16_t* WH = (bf16_t*)(ws + WS_WRH); bf16_t* WL = (bf16_t*)(ws + WS_WRL);
      for (int idx = blockIdx.x * NTHREADS + tid; idx < 48 * 2048; idx += G * NTHREADS) { const int n = idx >> 11, k = idx & 2047;
          float w = 0.f; if (n < 32) w = p.in(19)[(size_t)k * 32 + n]; else if (n < 36) w = p.in(17)[(size_t)k * 4 + (n - 32)];
          const unsigned short h = f2bf(w); WH[idx] = h; WL[idx] = f2bf(w - bf2f(h)); } }
}

__device__ __forceinline__ void p1_norm1(const KP& p, unsigned char* lds, int tid, int lane, int wave) {
    unsigned char* ws = p.ws; const float* MODP = (const float*)(ws + WS_MODP); const float* bada = p.in(3);
    float* A1 = (float*)lds; float* SH1 = A1 + 2048;
    for (int rbk = blockIdx.x; rbk < 256; rbk += gridDim.x) {
        const int b = rbk >> 6;
        __syncthreads();
        for (int k = tid; k < 2048; k += NTHREADS) { float sh = bada[k], sc = bada[2048 + k];
            for (int kc = 0; kc < NKC; ++kc) { const float* mp = MODP + ((size_t)kc * 4 + b) * 12288; sh += mp[k]; sc += mp[2048 + k]; }
            A1[k] = p.in(4)[k] * (1.0f + sc); SH1[k] = sh; }
        if (tid < 192) { const int idx = rbk * 192 + tid; const int bb = idx / 12288, j = idx % 12288; float s = bada[j];
            for (int kc = 0; kc < NKC; ++kc) s += MODP[((size_t)kc * 4 + bb) * 12288 + j];
            ((float*)(ws + WS_MODF))[idx] = s;
            if (j >= 6144 && j < 8192) ((float*)(ws + WS_SH2G))[bb * 2048 + (j - 6144)] = s;
            if (j >= 8192 && j < 10240) ((float*)(ws + WS_A2G))[bb * 2048 + (j - 8192)] = p.in(16)[j - 8192] * (1.0f + s); }
        __syncthreads();
        for (int i = 0; i < 4; ++i) { const int row = rbk * 32 + wave * 4 + i; const f32x4* xr = (const f32x4*)(p.in(0) + (size_t)row * DM) + lane;
            f32x4 v[8]; float s = 0.f;
#pragma unroll
            for (int j = 0; j < 8; ++j) { v[j] = xr[64 * j]; s += (v[j].x * v[j].x + v[j].y * v[j].y) + (v[j].z * v[j].z + v[j].w * v[j].w); }
            const float rstd = rsqrtf(wave_sum(s) * (1.0f / DM) + EPS);
            u32x2* o = (u32x2*)((bf16_t*)(ws + WS_H) + (size_t)row * DM) + lane;
#pragma unroll
            for (int j = 0; j < 8; ++j) { const int k = 4 * lane + 256 * j; const f32x4 a = *(const f32x4*)(A1 + k), sh = *(const f32x4*)(SH1 + k);
                const f32x4 h = v[j] * rstd * a + sh; u32x2 w; w.x = pk2(h.x, h.y); w.y = pk2(h.z, h.w); o[64 * j] = w; } }
    }
}

__device__ __forceinline__ int fetch_item(unsigned* ctr, volatile int* slot, int tid) {
    __syncthreads();
    if (tid == 0) *slot = (int)atomicAdd(ctr, 1u);
    __syncthreads();
    return *slot;
}

constexpr int KSTR = 72;
constexpr float ATT_C1 = 0.125f * LOG2E;

template <int VSTR>
__device__ __forceinline__ void pv_acc(const bf16_t* Vt, int kvo, const f32x16& pt, int l31, int hi, f32x16& o0, f32x16& o1) {
#pragma unroll
    for (int s = 0; s < 2; ++s) {
        u32x4 pw; pw.x = pk2(pt[8 * s + 0], pt[8 * s + 1]); pw.y = pk2(pt[8 * s + 2], pt[8 * s + 3]); pw.z = pk2(pt[8 * s + 4], pt[8 * s + 5]); pw.w = pk2(pt[8 * s + 6], pt[8 * s + 7]);
        const bf16x8 pb = __builtin_bit_cast(bf16x8, pw);
        const bf16_t* v0 = Vt + (size_t)l31 * VSTR + kvo + 16 * s + 4 * hi;
        const bf16_t* v1 = v0 + 32 * VSTR;
        const bf16x8 a0 = cat4(*(const s16x4*)v0, *(const s16x4*)(v0 + 8));
        const bf16x8 a1 = cat4(*(const s16x4*)v1, *(const s16x4*)(v1 + 8));
        o0 = mfma32(a0, pb, o0); o1 = mfma32(a1, pb, o1);
    }
}
__device__ __forceinline__ void attn_tile_update(const bf16_t* Ks, const bf16_t* Vt, const bf16x8 (&qf)[4], int l31, int hi,
                                                 float dist0, float kscale, float dlo, float dhi, bool laneok, float slope2,
                                                 f32x16& o0, f32x16& o1, float& m, float& l) {
    f32x16 s0, s1;
#pragma unroll
    for (int r = 0; r < 16; ++r) { s0[r] = 0.f; s1[r] = 0.f; }
#pragma unroll
    for (int ks = 0; ks < 4; ++ks) {
        const bf16x8 a0 = *(const bf16x8*)(Ks + l31 * KSTR + ks * 16 + hi * 8);
        const bf16x8 a1 = *(const bf16x8*)(Ks + (32 + l31) * KSTR + ks * 16 + hi * 8);
        s0 = mfma32(a0, qf[ks], s0); s1 = mfma32(a1, qf[ks], s1);
    }
    const float dbase = dist0 - kscale * (float)(4 * hi);
    float mt = -1e30f;
#pragma unroll
    for (int r = 0; r < 16; ++r) { const float c = (float)((r & 3) + 8 * (r >> 2));
        const float d0 = dbase - kscale * c, d1 = d0 - kscale * 32.0f;
        const float v0 = s0[r] * ATT_C1 - slope2 * d0, v1 = s1[r] * ATT_C1 - slope2 * d1;
        const bool ok0 = laneok && (d0 >= dlo) && (d0 < dhi), ok1 = laneok && (d1 >= dlo) && (d1 < dhi);
        s0[r] = ok0 ? v0 : -1e30f; s1[r] = ok1 ? v1 : -1e30f;
        mt = fmaxf(mt, fmaxf(s0[r], s1[r])); }
    mt = fmaxf(mt, __shfl_xor(mt, 32));
    const float mnew = fmaxf(m, mt); const float alpha = fexp2(m - mnew); m = mnew;
    float ps = 0.f;
#pragma unroll
    for (int r = 0; r < 16; ++r) { const float p0 = s0[r] > -1e29f ? fexp2(s0[r] - mnew) : 0.f, p1 = s1[r] > -1e29f ? fexp2(s1[r] - mnew) : 0.f;
        s0[r] = p0; s1[r] = p1; ps += p0 + p1; }
    l = l * alpha + ps;
#pragma unroll
    for (int r = 0; r < 16; ++r) { o0[r] *= alpha; o1[r] *= alpha; }
    pv_acc<KSTR>(Vt, 0, s0, l31, hi, o0, o1);
    pv_acc<KSTR>(Vt, 32, s1, l31, hi, o0, o1);
}
__device__ __forceinline__ void stage_kv(const bf16_t* kg, const bf16_t* vg, size_t pitch, bf16_t* Ks, bf16_t* Vt, int tid) {
    const int skv = tid >> 3, sp = tid & 7;
    const bf16x8 kreg = *(const bf16x8*)(kg + (size_t)skv * pitch + sp * 8);
    const bf16x8 vreg = *(const bf16x8*)(vg + (size_t)skv * pitch + sp * 8);
    __syncthreads();
    *(bf16x8*)(Ks + skv * KSTR + sp * 8) = kreg;
#pragma unroll
    for (int jj = 0; jj < 8; ++jj) Vt[(sp * 8 + jj) * KSTR + skv] = (bf16_t)vreg[jj];
    __syncthreads();
}

__device__ __forceinline__ void nsa_window_unit(const KP& p, unsigned char* lds, int b, int g, int qblk, int tid, int lane, int wave) {
    const bf16_t* P = (const bf16_t*)(p.ws + WS_P);
    bf16_t* Ks = (bf16_t*)lds; bf16_t* Vt = Ks + 64 * KSTR;
    const int l31 = lane & 31, hi = lane >> 5, r = wave >> 1, qh = wave & 1, h = 4 * g + r;
    const int tq = 64 * qblk + 32 * qh + l31; const size_t row = (size_t)b * SEQ + tq;
    const bf16_t* qp = P + row * PW + PC_Q + h * 64;
    bf16x8 qf[4];
#pragma unroll
    for (int ks = 0; ks < 4; ++ks) qf[ks] = *(const bf16x8*)(qp + 16 * ks + 8 * hi);
    const float slope2 = exp2f(-0.5f * (float)(h + 1)) * LOG2E;
    f32x16 o0, o1;
#pragma unroll
    for (int i = 0; i < 16; ++i) { o0[i] = 0.f; o1[i] = 0.f; }
    float m = -1e30f, l = 0.f;
    const int j0 = qblk > 8 ? qblk - 8 : 0;
    for (int j = j0; j <= qblk; ++j) {
        const bf16_t* kg = P + ((size_t)b * SEQ + 64 * j) * PW + PC_KW + g * 64;
        stage_kv(kg, kg + (PC_VW - PC_KW), PW, Ks, Vt, tid);
        attn_tile_update(Ks, Vt, qf, l31, hi, (float)(tq - 64 * j), 1.0f, 0.0f, 512.0f, true, slope2, o0, o1, m, l);
    }
    l += __shfl_xor(l, 32);
    const float gate = sigmoid_f(bf2f(P[row * PW + PC_GATE + h * 3 + 2]));
    const float sc = gate / l;
    bf16_t* ow = (bf16_t*)(p.ws + WS_OW) + row * 1024 + h * 64;
#pragma unroll
    for (int c4 = 0; c4 < 4; ++c4) { const int d = 8 * c4 + 4 * hi;
        u32x2 w0; w0.x = pk2(o0[4 * c4] * sc, o0[4 * c4 + 1] * sc); w0.y = pk2(o0[4 * c4 + 2] * sc, o0[4 * c4 + 3] * sc); *(u32x2*)(ow + d) = w0;
        u32x2 w1; w1.x = pk2(o1[4 * c4] * sc, o1[4 * c4 + 1] * sc); w1.y = pk2(o1[4 * c4 + 2] * sc, o1[4 * c4 + 3] * sc); *(u32x2*)(ow + 32 + d) = w1; }
}

__device__ __forceinline__ void nsa_cmp_sel_unit(const KP& p, unsigned char* lds, int b, int g, int qblk, int tid, int lane, int wave) {
    const bf16_t* P = (const bf16_t*)(p.ws + WS_P);
    bf16_t* Ks = (bf16_t*)lds; bf16_t* Vt = Ks + 64 * KSTR;
    bf16_t* KsC = (bf16_t*)(lds + 18432); bf16_t* VtC = (bf16_t*)(lds + 18432 + 128 * KSTR * 2);
    float* Gs = (float*)(lds + 55296); float* Ls = Gs + 4 * 64 * 32; float* IMP = Ls + 4 * 64 * 32; unsigned* SELM = (unsigned*)(IMP + 64 * 32);
    const int l31 = lane & 31, hi = lane >> 5, r = wave >> 1, qh = wave & 1, h = 4 * g + r, ql = 32 * qh + l31;
    const int tq = 64 * qblk + ql; const size_t row = (size_t)b * SEQ + tq;
    const bf16_t* qp = P + row * PW + PC_Q + h * 64;
    bf16x8 qf[4];
#pragma unroll
    for (int ks = 0; ks < 4; ++ks) qf[ks] = *(const bf16x8*)(qp + 16 * ks + 8 * hi);
    const float slope2 = exp2f(-0.5f * (float)(h + 1)) * LOG2E;
    const float g_c = sigmoid_f(bf2f(P[row * PW + PC_GATE + h * 3 + 0])), g_s = sigmoid_f(bf2f(P[row * PW + PC_GATE + h * 3 + 1]));
    f32x16 acc0, acc1;
    {
        const bf16_t* kc = (const bf16_t*)(p.ws + WS_KC) + (size_t)(b * 4 + g) * 128 * 64;
        const bf16_t* vct = (const bf16_t*)(p.ws + WS_VCT) + (size_t)(b * 4 + g) * 64 * 128;
        __syncthreads();
        for (int i = tid; i < 1024; i += NTHREADS) { const int n = i >> 3, sp = i & 7; *(bf16x8*)(KsC + n * KSTR + sp * 8) = *(const bf16x8*)(kc + n * 64 + sp * 8); }
        for (int i = tid; i < 1024; i += NTHREADS) { const int d = i >> 4, sp = i & 15; *(bf16x8*)(VtC + d * 136 + sp * 8) = *(const bf16x8*)(vct + d * 128 + sp * 8); }
        __syncthreads();
        f32x16 s[4];
#pragma unroll
        for (int t = 0; t < 4; ++t) {
#pragma unroll
            for (int i = 0; i < 16; ++i) s[t][i] = 0.f;
#pragma unroll
            for (int ks = 0; ks < 4; ++ks) { const bf16x8 a = *(const bf16x8*)(KsC + (32 * t + l31) * KSTR + ks * 16 + hi * 8); s[t] = mfma32(a, qf[ks], s[t]); } }
        const float dbase = (float)tq - 15.5f - 64.0f * (float)hi;
        float mt = -1e30f;
#pragma unroll
        for (int t = 0; t < 4; ++t)
#pragma unroll
            for (int i = 0; i < 16; ++i) { const float c = (float)(32 * t + (i & 3) + 8 * (i >> 2)); const float d = dbase - 16.0f * c;
                const float v = s[t][i] * ATT_C1 - slope2 * d; s[t][i] = (d >= 15.5f) ? v : -1e30f; mt = fmaxf(mt, s[t][i]); }
        mt = fmaxf(mt, __shfl_xor(mt, 32));
        float ps = 0.f;
#pragma unroll
        for (int t = 0; t < 4; ++t)
#pragma unroll
            for (int i = 0; i < 16; ++i) { const float pv = s[t][i] > -1e29f ? fexp2(s[t][i] - mt) : 0.f; s[t][i] = pv; ps += pv; }
        ps += __shfl_xor(ps, 32);
        const float linv = ps > 0.f ? 1.0f / ps : 0.f;
#pragma unroll
        for (int t = 0; t < 4; ++t)
#pragma unroll
            for (int i = 0; i < 16; ++i) s[t][i] *= linv;
#pragma unroll
        for (int t = 0; t < 4; ++t)
#pragma unroll
            for (int c4 = 0; c4 < 4; ++c4) { const int jj = 8 * t + 2 * c4 + hi; const int o = (r * 64 + ql) * 32 + jj;
                Gs[o] = (s[t][4 * c4] + s[t][4 * c4 + 1]) + (s[t][4 * c4 + 2] + s[t][4 * c4 + 3]); Ls[o] = s[t][4 * c4 + 3]; }
        f32x16 o0, o1;
#pragma unroll
        for (int i = 0; i < 16; ++i) { o0[i] = 0.f; o1[i] = 0.f; }
#pragma unroll
        for (int t = 0; t < 4; ++t) pv_acc<136>(VtC, 32 * t, s[t], l31, hi, o0, o1);
#pragma unroll
        for (int i = 0; i < 16; ++i) { acc0[i] = g_c * o0[i]; acc1[i] = g_c * o1[i]; }
    }
    __syncthreads();
    for (int idx = tid; idx < 64 * 32; idx += NTHREADS) { const int q = idx >> 5, j = idx & 31; float v = 0.f;
#pragma unroll
        for (int hh = 0; hh < 4; ++hh) { v += Gs[(hh * 64 + q) * 32 + j]; if (j > 0) v += Ls[(hh * 64 + q) * 32 + j - 1]; }
        IMP[idx] = v; }
    __syncthreads();
#pragma unroll 1
    for (int it = 0; it < 4; ++it) { const int q = 2 * (8 * it + wave) + (lane >> 5), j = lane & 31; bool sel;
        if (qblk < 16) sel = (j <= qblk);
        else { const bool forced = (j == 0) || (j == qblk) || (j == qblk - 1); const bool cand = (j >= 1) && (j <= qblk - 2);
            const float v = IMP[q * 32 + j]; int rank = 0;
            for (int j2 = 1; j2 <= qblk - 2; ++j2) { const float v2 = IMP[q * 32 + j2]; rank += (v2 > v || (v2 == v && j2 < j)) ? 1 : 0; }
            sel = forced || (cand && rank < 13); }
        const unsigned long long bm = __ballot(sel);
        if (j == 0) SELM[q] = (lane >> 5) ? (unsigned)(bm >> 32) : (unsigned)bm; }
    __syncthreads();
    unsigned um = 0u;
    for (int i = 0; i < 64; ++i) um |= SELM[i];
    const unsigned mymask = SELM[ql];
    {
        f32x16 o0, o1;
#pragma unroll
        for (int i = 0; i < 16; ++i) { o0[i] = 0.f; o1[i] = 0.f; }
        float m = -1e30f, l = 0.f;
        for (int j = 0; j <= qblk; ++j) {
            if (!((um >> j) & 1u)) continue;
            const bf16_t* kg = P + ((size_t)b * SEQ + 64 * j) * PW + PC_KS + g * 64;
            stage_kv(kg, kg + (PC_VS - PC_KS), PW, Ks, Vt, tid);
            attn_tile_update(Ks, Vt, qf, l31, hi, (float)(tq - 64 * j), 1.0f, 0.0f, 1e9f, ((mymask >> j) & 1u) != 0u, slope2, o0, o1, m, l);
        }
        l += __shfl_xor(l, 32);
        const float sc = g_s / l;
#pragma unroll
        for (int i = 0; i < 16; ++i) { acc0[i] += sc * o0[i]; acc1[i] += sc * o1[i]; }
    }
    const bf16_t* ow = (const bf16_t*)(p.ws + WS_OW) + row * 1024 + h * 64;
    bf16_t* mx = (bf16_t*)(p.ws + WS_H) + row * DM + h * 64;
#pragma unroll
    for (int c4 = 0; c4 < 4; ++c4) { const int d = 8 * c4 + 4 * hi;
        const u32x2 a = *(const u32x2*)(ow + d), bq = *(const u32x2*)(ow + 32 + d);
        const float w0 = acc0[4 * c4] + __uint_as_float(a.x << 16), w1 = acc0[4 * c4 + 1] + __uint_as_float(a.x & 0xffff0000u), w2 = acc0[4 * c4 + 2] + __uint_as_float(a.y << 16), w3 = acc0[4 * c4 + 3] + __uint_as_float(a.y & 0xffff0000u);
        const float x0 = acc1[4 * c4] + __uint_as_float(bq.x << 16), x1 = acc1[4 * c4 + 1] + __uint_as_float(bq.x & 0xffff0000u), x2 = acc1[4 * c4 + 2] + __uint_as_float(bq.y << 16), x3 = acc1[4 * c4 + 3] + __uint_as_float(bq.y & 0xffff0000u);
        u32x2 o; o.x = pk2(w0, w1); o.y = pk2(w2, w3); *(u32x2*)(mx + d) = o;
        u32x2 o2; o2.x = pk2(x0, x1); o2.y = pk2(x2, x3); *(u32x2*)(mx + 32 + d) = o2; }
}

__device__ __forceinline__ float gelu_tanh(float x) { const float u = 0.7978845608028654f * (x + 0.044715f * x * x * x); const float e = fexp(2.0f * u); return 0.5f * x * (2.0f - 2.0f / (e + 1.0f)); }
__device__ __forceinline__ void nsa_compress_unit(const KP& p, unsigned char* lds, int cu, int tid, int lane, int wave) {
    const int kv = cu >> 7, b = (cu >> 5) & 3, g = (cu >> 3) & 3, nt = cu & 7;
    const bf16_t* P = (const bf16_t*)(p.ws + WS_P);
    const bf16_t* W1T = (const bf16_t*)(p.ws + (kv ? WS_W1TV : WS_W1TK)); const bf16_t* W2T = (const bf16_t*)(p.ws + (kv ? WS_W2TV : WS_W2TK));
    float* PART = (float*)lds;
    bf16_t* HS = (bf16_t*)(lds + 32768);
    const int fr = lane & 15, fq = lane >> 4;
    int n = 16 * nt + fr; if (n > 126) n = 126;
    const int colbase = (kv ? PC_VC : PC_KC) + g * 64;
    f32x4 acc[4];
#pragma unroll
    for (int i = 0; i < 4; ++i) acc[i] = (f32x4){0.f, 0.f, 0.f, 0.f};
#pragma unroll
    for (int ks = 0; ks < 8; ++ks) { const int kg = 256 * wave + 32 * ks + 8 * fq; const int t = kg >> 6, d = kg & 63;
        const bf16x8 a = *(const bf16x8*)(P + ((size_t)b * SEQ + 16 * n + t) * PW + colbase + d);
#pragma unroll
        for (int ntile = 0; ntile < 4; ++ntile) { const bf16x8 bb = *(const bf16x8*)(W1T + (size_t)(ntile * 16 + fr) * 2048 + kg); acc[ntile] = mfma16(a, bb, acc[ntile]); } }
    __syncthreads();
#pragma unroll
    for (int ntile = 0; ntile < 4; ++ntile)
#pragma unroll
        for (int i = 0; i < 4; ++i) PART[(wave * 16 + fq * 4 + i) * 64 + ntile * 16 + fr] = acc[ntile][i];
    __syncthreads();
    { const int rr = tid >> 5, c2 = (tid & 31) * 2; float v0 = ((const float*)(p.ws + WS_POSW1))[kv * 64 + c2], v1 = ((const float*)(p.ws + WS_POSW1))[kv * 64 + c2 + 1];
#pragma unroll
      for (int w = 0; w < 8; ++w) { v0 += PART[(w * 16 + rr) * 64 + c2]; v1 += PART[(w * 16 + rr) * 64 + c2 + 1]; }
      *(unsigned*)(HS + rr * KSTR + c2) = pk2(gelu_tanh(v0), gelu_tanh(v1)); }
    __syncthreads();
    if (wave < 4) { f32x4 a2 = (f32x4){0.f, 0.f, 0.f, 0.f};
#pragma unroll
        for (int s = 0; s < 2; ++s) { const bf16x8 a = *(const bf16x8*)(HS + fr * KSTR + 32 * s + 8 * fq); const bf16x8 bb = *(const bf16x8*)(W2T + (wave * 16 + fr) * 64 + 32 * s + 8 * fq); a2 = mfma16(a, bb, a2); }
        const int d = wave * 16 + fr;
#pragma unroll
        for (int i = 0; i < 4; ++i) { const int nn = 16 * nt + fq * 4 + i; const float val = nn <= 126 ? a2[i] : 0.f;
            if (kv == 0) ((bf16_t*)(p.ws + WS_KC))[((size_t)(b * 4 + g) * 128 + nn) * 64 + d] = f2bf(val);
            else ((bf16_t*)(p.ws + WS_VCT))[((size_t)(b * 4 + g) * 64 + d) * 128 + nn] = f2bf(val); } }
}

__device__ __forceinline__ void gla_a_unit(const KP& p, unsigned char* lds, int u, int tid, int lane, int wave) {
    const bf16_t* P = (const bf16_t*)(p.ws + WS_P);
    const int c = u & 31, h = (u >> 5) & 3, b = u >> 7;
    float* BL = (float*)lds;
    bf16_t* QT = (bf16_t*)(lds + 32768);
    bf16_t* KH = (bf16_t*)(lds + 50176);
    bf16_t* KTt = (bf16_t*)(lds + 67584);
    bf16_t* VT = (bf16_t*)(lds + 86016);
    bf16_t* AT = (bf16_t*)(lds + 122880);
    float* SEG = (float*)(lds + 132096);
    float* LR = (float*)(lds + 122880);
    float* WG = (float*)(lds + 134144);
    const int l31 = lane & 31, hi = lane >> 5;
    const int gk = tid & 127, seg = tid >> 7;
    const size_t row0 = (size_t)b * SEQ + 64 * c;
    const float qscale = 0.08838834764831845f;
    const float bg = p.in(13)[h * 128 + gk];
    const unsigned short lr0 = P[(row0 + (tid >> 4)) * PW + PC_LR + (tid & 15)], lr1 = P[(row0 + 32 + (tid >> 4)) * PW + PC_LR + (tid & 15)];
    bf16x8 qv[2], kv[2], vv[4];
#pragma unroll
    for (int ps = 0; ps < 2; ++ps) { const int i = 32 * ps + (tid >> 4), k8 = (tid & 15) * 8;
        qv[ps] = *(const bf16x8*)(P + (row0 + i) * PW + PC_GQ + h * 128 + k8); kv[ps] = *(const bf16x8*)(P + (row0 + i) * PW + PC_GK + h * 128 + k8); }
#pragma unroll
    for (int ps = 0; ps < 4; ++ps) { const int i = 16 * ps + (tid >> 5), d8 = (tid & 31) * 8; vv[ps] = *(const bf16x8*)(P + (row0 + i) * PW + PC_GV + h * 256 + d8); }
    __syncthreads();
    for (int i = tid; i < 2048; i += NTHREADS) WG[i] = p.in(12)[(i >> 7) * 512 + h * 128 + (i & 127)];
    LR[tid] = bf2f(lr0); LR[512 + tid] = bf2f(lr1);
    __syncthreads();
    { float run = 0.f;
      for (int ii = 0; ii < 16; ++ii) { const int i = 16 * seg + ii; float z = bg;
#pragma unroll
          for (int r = 0; r < 16; ++r) z += LR[i * 16 + r] * WG[r * 128 + gk];
          const float la = (fminf(z, 0.f) - __logf(1.0f + __expf(-fabsf(z)))) * 0.0625f;
          run += la; BL[i * 128 + gk] = run; }
      SEG[seg * 128 + gk] = run; }
    __syncthreads();
    if (tid < 128) ((float*)(p.ws + WS_GDEC))[(size_t)u * 128 + tid] = __expf(SEG[tid] + SEG[128 + tid] + SEG[256 + tid] + SEG[384 + tid]);
#pragma unroll
    for (int ps = 0; ps < 2; ++ps) { const int i = 32 * ps + (tid >> 4), k8 = (tid & 15) * 8; const int sg = i >> 4;
        float qe[8], ke[8];
#pragma unroll
        for (int j = 0; j < 8; ++j) { const int k = k8 + j; float pre = 0.f, tot = 0.f;
#pragma unroll
            for (int s2 = 0; s2 < 4; ++s2) { const float sv = SEG[s2 * 128 + k]; tot += sv; if (s2 < sg) pre += sv; }
            const float bb = BL[i * 128 + k] + pre; const float kf = bf2f((unsigned short)kv[ps][j]);
            qe[j] = bf2f((unsigned short)qv[ps][j]) * qscale * __expf(bb); ke[j] = kf * __expf(-bb);
            KTt[k * KSTR + i] = f2bf(kf * __expf(tot - bb)); }
        u32x4 w; w.x = pk2(qe[0], qe[1]); w.y = pk2(qe[2], qe[3]); w.z = pk2(qe[4], qe[5]); w.w = pk2(qe[6], qe[7]); *(u32x4*)(QT + i * 136 + k8) = w;
        *(u32x4*)((bf16_t*)(p.ws + WS_GQT) + ((size_t)u * 64 + i) * 128 + k8) = w;
        u32x4 w2; w2.x = pk2(ke[0], ke[1]); w2.y = pk2(ke[2], ke[3]); w2.z = pk2(ke[4], ke[5]); w2.w = pk2(ke[6], ke[7]); *(u32x4*)(KH + i * 136 + k8) = w2; }
#pragma unroll
    for (int ps = 0; ps < 4; ++ps) { const int i = 16 * ps + (tid >> 5), d8 = (tid & 31) * 8;
#pragma unroll
        for (int j = 0; j < 8; ++j) VT[(d8 + j) * KSTR + i] = (bf16_t)vv[ps][j]; }
    __syncthreads();
    if (wave < 4) { const int jt = wave >> 1, itl = wave & 1;
        f32x16 cacc;
#pragma unroll
        for (int i = 0; i < 16; ++i) cacc[i] = 0.f;
        if (!(jt == 1 && itl == 0)) {
#pragma unroll
            for (int ks = 0; ks < 8; ++ks) { const bf16x8 a = *(const bf16x8*)(KH + (32 * jt + l31) * 136 + 16 * ks + 8 * hi); const bf16x8 bb = *(const bf16x8*)(QT + (32 * itl + l31) * 136 + 16 * ks + 8 * hi); cacc = mfma32(a, bb, cacc); } }
        const int i = 32 * itl + l31;
#pragma unroll
        for (int c4 = 0; c4 < 4; ++c4) { const int jb = 32 * jt + 8 * c4 + 4 * hi;
            const float a0 = (jb + 0 <= i) ? cacc[4 * c4 + 0] : 0.f, a1 = (jb + 1 <= i) ? cacc[4 * c4 + 1] : 0.f, a2 = (jb + 2 <= i) ? cacc[4 * c4 + 2] : 0.f, a3 = (jb + 3 <= i) ? cacc[4 * c4 + 3] : 0.f;
            u32x2 w; w.x = pk2(a0, a1); w.y = pk2(a2, a3); *(u32x2*)(AT + i * KSTR + jb) = w; } }
    __syncthreads();
    { f32x16 oT[2];
#pragma unroll
      for (int i = 0; i < 16; ++i) { oT[0][i] = 0.f; oT[1][i] = 0.f; }
#pragma unroll
      for (int s4 = 0; s4 < 4; ++s4) { const bf16x8 a = *(const bf16x8*)(VT + (32 * wave + l31) * KSTR + 16 * s4 + 8 * hi);
          oT[0] = mfma32(a, *(const bf16x8*)(AT + l31 * KSTR + 16 * s4 + 8 * hi), oT[0]);
          oT[1] = mfma32(a, *(const bf16x8*)(AT + (32 + l31) * KSTR + 16 * s4 + 8 * hi), oT[1]); }
      bf16_t* oi = (bf16_t*)(p.ws + WS_GOI) + (size_t)u * 64 * 256 + 32 * wave;
#pragma unroll
      for (int itl = 0; itl < 2; ++itl)
#pragma unroll
          for (int c4 = 0; c4 < 4; ++c4) { u32x2 w; w.x = pk2(oT[itl][4 * c4], oT[itl][4 * c4 + 1]); w.y = pk2(oT[itl][4 * c4 + 2], oT[itl][4 * c4 + 3]);
              *(u32x2*)(oi + (size_t)(32 * itl + l31) * 256 + 8 * c4 + 4 * hi) = w; } }
    { f32x16 D[4];
#pragma unroll
      for (int dkt = 0; dkt < 4; ++dkt) {
#pragma unroll
          for (int i = 0; i < 16; ++i) D[dkt][i] = 0.f;
#pragma unroll
          for (int s4 = 0; s4 < 4; ++s4) { const bf16x8 a = *(const bf16x8*)(KTt + (32 * dkt + l31) * KSTR + 16 * s4 + 8 * hi); const bf16x8 bb = *(const bf16x8*)(VT + (32 * wave + l31) * KSTR + 16 * s4 + 8 * hi); D[dkt] = mfma32(a, bb, D[dkt]); } }
      __syncthreads();
      bf16_t* st = (bf16_t*)lds + wave * (32 * 136);
#pragma unroll
      for (int dkt = 0; dkt < 4; ++dkt)
#pragma unroll
          for (int c4 = 0; c4 < 4; ++c4) { u32x2 w; w.x = pk2(D[dkt][4 * c4], D[dkt][4 * c4 + 1]); w.y = pk2(D[dkt][4 * c4 + 2], D[dkt][4 * c4 + 3]);
              *(u32x2*)(st + l31 * 136 + 32 * dkt + 8 * c4 + 4 * hi) = w; }
      asm volatile("s_waitcnt lgkmcnt(0)" ::: "memory");
      bf16_t* ds = (bf16_t*)(p.ws + WS_GDS) + ((size_t)u * 256 + 32 * wave) * 128;
#pragma unroll
      for (int it = 0; it < 8; ++it) { const int rr = it * 4 + (lane >> 4), ch = lane & 15; *(u32x4*)(ds + (size_t)rr * 128 + ch * 8) = *(const u32x4*)(st + rr * 136 + ch * 8); } }
}
__device__ __forceinline__ void gla_scan(const KP& p, int tid) {
    const bf16_t* DS = (const bf16_t*)(p.ws + WS_GDS); bf16_t* SS = (bf16_t*)(p.ws + WS_GSS); const float* DEC = (const float*)(p.ws + WS_GDEC);
    for (int gt = blockIdx.x * NTHREADS + tid; gt < 16 * 8192; gt += gridDim.x * NTHREADS) { const int bh = gt >> 13, rem = gt & 8191, dv = rem >> 5, dk4 = (rem & 31) * 4;
        float s0 = 0.f, s1 = 0.f, s2 = 0.f, s3 = 0.f;
#pragma unroll 8
        for (int c = 0; c < 32; ++c) { const size_t u = (size_t)bh * 32 + c; const size_t o = (u * 256 + dv) * 128 + dk4;
            const u32x2 d = *(const u32x2*)(DS + o); const f32x4 dec = *(const f32x4*)(DEC + u * 128 + dk4);
            u32x2 w; w.x = pk2(s0, s1); w.y = pk2(s2, s3); *(u32x2*)(SS + o) = w;
            s0 = dec.x * s0 + __uint_as_float(d.x << 16); s1 = dec.y * s1 + __uint_as_float(d.x & 0xffff0000u); s2 = dec.z * s2 + __uint_as_float(d.y << 16); s3 = dec.w * s3 + __uint_as_float(d.y & 0xffff0000u); } }
}
__device__ __forceinline__ void gla_c_unit(const KP& p, unsigned char* lds, int u, int tid, int lane, int wave) {
    const bf16_t* P = (const bf16_t*)(p.ws + WS_P);
    const int c = u & 31, h = (u >> 5) & 3, b = u >> 7;
    float* SSQ = (float*)lds;
    const int l31 = lane & 31, hi = lane >> 5;
    const size_t row0 = (size_t)b * SEQ + 64 * c;
    const bf16_t* SS = (const bf16_t*)(p.ws + WS_GSS) + ((size_t)u * 256 + 32 * wave + l31) * 128 + 8 * hi;
    const bf16_t* QG = (const bf16_t*)(p.ws + WS_GQT) + ((size_t)u * 64 + l31) * 128 + 8 * hi;
    f32x16 oT[2];
#pragma unroll
    for (int i = 0; i < 16; ++i) { oT[0][i] = 0.f; oT[1][i] = 0.f; }
#pragma unroll
    for (int ks = 0; ks < 8; ++ks) { const bf16x8 a = *(const bf16x8*)(SS + 16 * ks);
        oT[0] = mfma32(a, *(const bf16x8*)(QG + 16 * ks), oT[0]); oT[1] = mfma32(a, *(const bf16x8*)(QG + 32 * 128 + 16 * ks), oT[1]); }
    const bf16_t* oi = (const bf16_t*)(p.ws + WS_GOI) + (size_t)u * 64 * 256 + 32 * wave;
#pragma unroll
    for (int itl = 0; itl < 2; ++itl)
#pragma unroll
        for (int c4 = 0; c4 < 4; ++c4) { const u32x2 w = *(const u32x2*)(oi + (size_t)(32 * itl + l31) * 256 + 8 * c4 + 4 * hi);
            oT[itl][4 * c4] += __uint_as_float(w.x << 16); oT[itl][4 * c4 + 1] += __uint_as_float(w.x & 0xffff0000u); oT[itl][4 * c4 + 2] += __uint_as_float(w.y << 16); oT[itl][4 * c4 + 3] += __uint_as_float(w.y & 0xffff0000u); }
    { float q0 = 0.f, q1 = 0.f;
#pragma unroll
      for (int i = 0; i < 16; ++i) { q0 += oT[0][i] * oT[0][i]; q1 += oT[1][i] * oT[1][i]; }
      q0 += __shfl_xor(q0, 32); q1 += __shfl_xor(q1, 32);
      if (hi == 0) { SSQ[wave * 64 + l31] = q0; SSQ[wave * 64 + 32 + l31] = q1; } }
    __syncthreads();
#pragma unroll
    for (int itl = 0; itl < 2; ++itl) { const int i = 32 * itl + l31; float tot = 0.f;
#pragma unroll
        for (int w = 0; w < 8; ++w) tot += SSQ[w * 64 + i];
        const float rstd = rsqrtf(tot * (1.0f / 256.0f) + EPS);
        const bf16_t* og = P + (row0 + i) * PW + PC_GO + h * 256 + 32 * wave;
        bf16_t* mx = (bf16_t*)(p.ws + WS_H) + (row0 + i) * DM + 1024 + h * 256 + 32 * wave;
#pragma unroll
        for (int c4 = 0; c4 < 4; ++c4) { const int d = 8 * c4 + 4 * hi; const u32x2 gq = *(const u32x2*)(og + d);
            const f32x4 nw = *(const f32x4*)(p.in(14) + 32 * wave + d);
            const float g0 = __uint_as_float(gq.x << 16), g1 = __uint_as_float(gq.x & 0xffff0000u), g2 = __uint_as_float(gq.y << 16), g3 = __uint_as_float(gq.y & 0xffff0000u);
            const float v0 = oT[itl][4 * c4] * rstd * nw.x * pg8::silu_f(g0), v1 = oT[itl][4 * c4 + 1] * rstd * nw.y * pg8::silu_f(g1), v2 = oT[itl][4 * c4 + 2] * rstd * nw.z * pg8::silu_f(g2), v3 = oT[itl][4 * c4 + 3] * rstd * nw.w * pg8::silu_f(g3);
            u32x2 o; o.x = pk2(v0, v1); o.y = pk2(v2, v3); *(u32x2*)(mx + d) = o; } }
}

__device__ __forceinline__ void p6_norm2_route(const KP& p, unsigned char* lds, int tid, int lane, int wave) {
    unsigned char* ws = p.ws; const float* X2 = p.out; bf16_t* H2 = (bf16_t*)(ws + WS_H);
    const bf16_t* WRH = (const bf16_t*)(ws + WS_WRH); const bf16_t* WRL = (const bf16_t*)(ws + WS_WRL);
    float* LG = (float*)(lds + wave * 4096);
    const int fr = lane & 15, fq = lane >> 4;
    unsigned* ctl = (unsigned*)(ws + WS_CTL);
    for (int task = wave * gridDim.x + blockIdx.x; task < 512; task += NWAVES * gridDim.x) {
        const int row0 = 16 * task, b = row0 >> 11;
        float myrstd = 0.f;
        for (int rr = 0; rr < 16; ++rr) { const f32x4* xr = (const f32x4*)(X2 + (size_t)(row0 + rr) * DM) + lane; float s = 0.f;
#pragma unroll
            for (int j = 0; j < 8; ++j) { const f32x4 v = xr[64 * j]; s += (v.x * v.x + v.y * v.y) + (v.z * v.z + v.w * v.w); }
            const float tot = wave_sum(s); if (fr == rr) myrstd = rsqrtf(tot * (1.0f / DM) + EPS); }
        const float* xrow = X2 + (size_t)(row0 + fr) * DM; const float* a2 = (const float*)(ws + WS_A2G) + b * 2048; const float* s2 = (const float*)(ws + WS_SH2G) + b * 2048;
        bf16_t* hrow = H2 + (size_t)(row0 + fr) * DM;
        f32x4 acc[3];
#pragma unroll
        for (int i = 0; i < 3; ++i) acc[i] = (f32x4){0.f, 0.f, 0.f, 0.f};
#pragma unroll 2
        for (int ks = 0; ks < 64; ++ks) { const int k0 = 32 * ks + 8 * fq;
            const f32x4 x0 = *(const f32x4*)(xrow + k0), x1 = *(const f32x4*)(xrow + k0 + 4), aa0 = *(const f32x4*)(a2 + k0), aa1 = *(const f32x4*)(a2 + k0 + 4), ss0 = *(const f32x4*)(s2 + k0), ss1 = *(const f32x4*)(s2 + k0 + 4);
            const f32x4 h0 = x0 * myrstd * aa0 + ss0, h1 = x1 * myrstd * aa1 + ss1;
            u32x4 hw; hw.x = pk2(h0.x, h0.y); hw.y = pk2(h0.z, h0.w); hw.z = pk2(h1.x, h1.y); hw.w = pk2(h1.z, h1.w);
            *(u32x4*)(hrow + k0) = hw;
            u32x4 lw; lw.x = pk2(h0.x - __uint_as_float(hw.x << 16), h0.y - __uint_as_float(hw.x & 0xffff0000u)); lw.y = pk2(h0.z - __uint_as_float(hw.y << 16), h0.w - __uint_as_float(hw.y & 0xffff0000u));
            lw.z = pk2(h1.x - __uint_as_float(hw.z << 16), h1.y - __uint_as_float(hw.z & 0xffff0000u)); lw.w = pk2(h1.z - __uint_as_float(hw.w << 16), h1.w - __uint_as_float(hw.w & 0xffff0000u));
            const bf16x8 hf = __builtin_bit_cast(bf16x8, hw), lf = __builtin_bit_cast(bf16x8, lw);
#pragma unroll
            for (int nt = 0; nt < 3; ++nt) { const bf16x8 bh = *(const bf16x8*)(WRH + (size_t)(nt * 16 + fr) * 2048 + k0), bl = *(const bf16x8*)(WRL + (size_t)(nt * 16 + fr) * 2048 + k0);
                acc[nt] = mfma16(hf, bh, acc[nt]); acc[nt] = mfma16(hf, bl, acc[nt]); acc[nt] = mfma16(lf, bh, acc[nt]); } }
#pragma unroll
        for (int nt = 0; nt < 3; ++nt)
#pragma unroll
            for (int i = 0; i < 4; ++i) LG[(fq * 4 + i) * 49 + nt * 16 + fr] = acc[nt][i];
        asm volatile("s_waitcnt lgkmcnt(0)" ::: "memory");
        if (lane < 16) { const float* lg = LG + lane * 49; const int tok = row0 + lane;
            float gl[4]; int grp = 0; float gmax = -1e30f;
#pragma unroll
            for (int j = 0; j < 4; ++j) { gl[j] = lg[32 + j] + p.in(18)[j]; if (gl[j] > gmax) { gmax = gl[j]; grp = j; } }
            float gs = 0.f;
#pragma unroll
            for (int j = 0; j < 4; ++j) gs += __expf(gl[j] - gmax);
            const float grp_p = 1.0f / gs;
            float v1 = -1e30f, v2 = -1e30f; int i1 = 0, i2 = 0;
            for (int j = 0; j < 8; ++j) { const float v = lg[grp * 8 + j] + p.in(20)[grp * 8 + j];
                if (v > v1) { v2 = v1; i2 = i1; v1 = v; i1 = j; } else if (v > v2) { v2 = v; i2 = j; } }
            const float e2 = __expf(v2 - v1); const float w1 = grp_p / (1.0f + e2), w2 = grp_p * e2 / (1.0f + e2);
            const int ea = grp * 8 + i1, eb = grp * 8 + i2;
            const int pa = (int)atomicAdd(ctl + CW_ECNT + 16 * ea, 1u), pb = (int)atomicAdd(ctl + CW_ECNT + 16 * eb, 1u);
            int* te = (int*)(ws + WS_TOKE); float* tw = (float*)(ws + WS_TOKW); int* tp = (int*)(ws + WS_TOKP);
            te[2 * tok] = ea; te[2 * tok + 1] = eb; tw[2 * tok] = w1; tw[2 * tok + 1] = w2; tp[2 * tok] = pa; tp[2 * tok + 1] = pb; }
        asm volatile("s_waitcnt lgkmcnt(0)" ::: "memory");
    }
}

__device__ __forceinline__ void p7_dispatch(const KP& p, unsigned char* lds, int tid, int lane, int wave) {
    unsigned char* ws = p.ws; unsigned* ctl = (unsigned*)(ws + WS_CTL);
    int* PST = (int*)lds;
    volatile int* PSTv = (volatile int*)PST;
    if (tid < 32) PSTv[64 + tid] = (int)__hip_atomic_load(ctl + CW_ECNT + 16 * tid, __ATOMIC_RELAXED, __HIP_MEMORY_SCOPE_AGENT);
    __syncthreads();
    if (tid == 0) { int acc = 0;
#pragma unroll 1
        for (int e = 0; e < 32; ++e) { const int c = PSTv[64 + e]; PSTv[e] = acc; acc += (c + 255) & ~255; } PSTv[32] = acc; }
    __syncthreads();
    int* slot_tok = (int*)(ws + WS_SLOTT); float* slot_w = (float*)(ws + WS_SLOTW); int* rbe = (int*)(ws + WS_RBE);
    if (blockIdx.x == 0) {
        const int nrb = PST[32] >> 8;
        if (tid == 0) rbe[128] = nrb;
        for (int rb = tid; rb < nrb; rb += NTHREADS) { int e = 0;
#pragma unroll 1
            for (int q = 0; q < 32; ++q) if (PSTv[q] <= rb * 256 && rb * 256 < PSTv[q + 1]) e = q;
            rbe[rb] = e; }
#pragma unroll 1
        for (int e = 0; e < 32; ++e) { const int s0 = PSTv[e] + PSTv[64 + e], s1 = PSTv[e + 1]; for (int s = s0 + tid; s < s1; s += NTHREADS) slot_tok[s] = -1; }
    }
    const int gw = blockIdx.x * NWAVES + wave, NGW = gridDim.x * NWAVES;
    const int* te = (const int*)(ws + WS_TOKE); const float* tw = (const float*)(ws + WS_TOKW); const int* tp = (const int*)(ws + WS_TOKP);
    const bf16_t* H2 = (const bf16_t*)(ws + WS_H); bf16_t* XS = (bf16_t*)(ws + WS_P);
    for (int pair = gw; pair < 16384; pair += NGW) { const int tok = pair >> 1; const int e = te[pair], pos = tp[pair]; const int slot = PST[e] + pos;
        const u32x4* src = (const u32x4*)(H2 + (size_t)tok * DM) + lane; u32x4* dst = (u32x4*)(XS + (size_t)slot * DM) + lane;
#pragma unroll
        for (int j = 0; j < 4; ++j) dst[64 * j] = src[64 * j];
        if (lane == 0) { slot_tok[slot] = pair; slot_w[slot] = tw[pair]; } }
}

__device__ __forceinline__ void p10_final(const KP& p, int tid, int lane, int wave) {
    unsigned char* ws = p.ws; const bf16_t* Y = (const bf16_t*)(ws + WS_P); const float* MODF = (const float*)(ws + WS_MODF);
    const int gw = blockIdx.x * NWAVES + wave, NGW = gridDim.x * NWAVES;
    for (int row = gw; row < NTOK; row += NGW) { const int b = row >> 11;
        f32x4* xr = (f32x4*)(p.out + (size_t)row * DM) + lane; const u32x2* y0 = (const u32x2*)(Y + (size_t)(2 * row) * DM) + lane; const u32x2* y1 = (const u32x2*)(Y + (size_t)(2 * row + 1) * DM) + lane;
        const f32x4* g2 = (const f32x4*)(MODF + (size_t)b * 12288 + 10240) + lane; const f32x4* nf = (const f32x4*)p.in(24) + lane;
        f32x4 v[8]; float s = 0.f;
#pragma unroll
        for (int j = 0; j < 8; ++j) { const f32x4 x = xr[64 * j]; const u32x2 a = y0[64 * j], c = y1[64 * j]; const f32x4 gg = g2[64 * j];
            f32x4 ys; ys.x = __uint_as_float(a.x << 16) + __uint_as_float(c.x << 16); ys.y = __uint_as_float(a.x & 0xffff0000u) + __uint_as_float(c.x & 0xffff0000u);
            ys.z = __uint_as_float(a.y << 16) + __uint_as_float(c.y << 16); ys.w = __uint_as_float(a.y & 0xffff0000u) + __uint_as_float(c.y & 0xffff0000u);
            v[j] = x + gg * ys; s += (v[j].x * v[j].x + v[j].y * v[j].y) + (v[j].z * v[j].z + v[j].w * v[j].w); }
        const float rstd = rsqrtf(wave_sum(s) * (1.0f / DM) + EPS);
#pragma unroll
        for (int j = 0; j < 8; ++j) xr[64 * j] = v[j] * rstd * nf[64 * j]; }
}

#define XB_TMO      128
#define XB_XCNT(j)  (256  + 64 * (j))
#define XB_XSUB(j)  (1280 + 64 * (j))
#define XB_XGEN(j)  (2304 + 64 * (j))
#define XB_TOP      3328
#define XB_TOPGEN   3392
#define XCD_BAR_WORDS 3456
#define XB_SPIN_CAP (1u << 18)

__device__ __forceinline__ unsigned xb_ld(unsigned* p)              { return __hip_atomic_load(p, __ATOMIC_RELAXED, __HIP_MEMORY_SCOPE_AGENT); }
__device__ __forceinline__ unsigned xb_add(unsigned* p, unsigned v) { return __hip_atomic_fetch_add(p, v, __ATOMIC_RELAXED, __HIP_MEMORY_SCOPE_AGENT); }
__device__ __forceinline__ unsigned xb_xcc_id() { return (unsigned)__builtin_amdgcn_s_getreg((3 << 11) | 20) & 0xFu; }
#define XB_SPIN(cond, bar) do { unsigned _sp = 0; while (cond) { __builtin_amdgcn_s_sleep(1); \
    if ((++_sp & 255u) == 0u) { if (xb_ld(&(bar)[XB_TMO])) break; if (_sp > XB_SPIN_CAP) { atomicAdd(&(bar)[XB_TMO], 1u); break; } } } } while (0)

struct XcdBarrier {
    unsigned* bar; unsigned x;
    volatile LAS unsigned* st;
};

__device__ __forceinline__ XcdBarrier xcd_barrier_post(unsigned* bar, volatile LAS unsigned* st) {
    XcdBarrier b; b.bar = bar; b.x = xb_xcc_id(); b.st = st;
    if (threadIdx.x == 0) (void)xb_add(&bar[XB_XCNT(b.x)], 1u);
    return b;
}
__device__ __forceinline__ void xcd_barrier_complete(unsigned* bar, unsigned x, unsigned& nloc, unsigned& nx) {
    const unsigned G = gridDim.x * gridDim.y * gridDim.z;
    unsigned sum, cnt, mine, sp = 0u;
    for (;;) {
        sum = 0u; cnt = 0u; mine = 0u;
#pragma unroll
        for (unsigned j = 0; j < 16; ++j) { const unsigned c = xb_ld(&bar[XB_XCNT(j)]); sum += c; cnt += (c > 0u) ? 1u : 0u; mine = (j == x) ? c : mine; }
        if (sum == G) break;
        __builtin_amdgcn_s_sleep(1);
        if ((++sp & 255u) == 0u) { if (xb_ld(&bar[XB_TMO])) break; if (sp > XB_SPIN_CAP) { atomicAdd(&bar[XB_TMO], 1u); break; } }
    }
    nloc = mine > 0u ? mine : 1u; nx = cnt > 0u ? cnt : 1u;
}

__device__ __forceinline__ void xcd_barrier(const XcdBarrier& b) {
    asm volatile("s_waitcnt vmcnt(0)" ::: "memory");
    __syncthreads();
    if (threadIdx.x == 0) {
        unsigned* bar = b.bar;
        __builtin_amdgcn_s_waitcnt(0);
        unsigned nloc = b.st[0], nx = b.st[1];
        if (nloc == 0u) { xcd_barrier_complete(bar, b.x, nloc, nx); b.st[0] = nloc; b.st[1] = nx; }
        const unsigned old = xb_add(&bar[XB_XSUB(b.x)], 1u);
        const unsigned gen = old / nloc;
        if (old + 1u == (gen + 1u) * nloc) {
            __builtin_amdgcn_fence(__ATOMIC_RELEASE, "agent");
            asm volatile("s_waitcnt vmcnt(0)" ::: "memory");
            const unsigned og = xb_add(&bar[XB_TOP], 1u);
            const unsigned tg = og / nx;
            if (og + 1u == (tg + 1u) * nx) xb_add(&bar[XB_TOPGEN], 1u);
            else XB_SPIN(xb_ld(&bar[XB_TOPGEN]) == tg, bar);
            __builtin_amdgcn_fence(__ATOMIC_ACQUIRE, "agent");
            xb_add(&bar[XB_XGEN(b.x)], 1u);
            asm volatile("s_waitcnt vmcnt(0)" ::: "memory");
        } else {
            XB_SPIN(xb_ld(&bar[XB_XGEN(b.x)]) == gen, bar);
            __builtin_amdgcn_fence(__ATOMIC_ACQUIRE, "agent");
            asm volatile("s_waitcnt vmcnt(0)" ::: "memory");
        }
    }
    __syncthreads();
}

__global__ void __launch_bounds__(NTHREADS, 2) fwd_megakernel(Params kargs) {
    extern __shared__ __attribute__((aligned(16))) unsigned char lds[];
    KP p; p.tab = (volatile LAS unsigned long long*)((LAS unsigned char*)lds + LDS_BYTES - 512); p.out = kargs.out; p.ws = kargs.ws;
    if (threadIdx.x == 0) {
#pragma unroll
        for (int i = 0; i < 25; ++i) p.tab[i] = (unsigned long long)kargs.in[i]; }
    __syncthreads();
    cg::grid_group grid = cg::this_grid();
    const int tid0 = threadIdx.x;
#define PHASE_IDS int tid = threadIdx.x; asm volatile("" : "+v"(tid)); const int lane = tid & 63, wave = __builtin_amdgcn_readfirstlane(tid >> 6); (void)lane; (void)wave;
    unsigned char* ws = p.ws; unsigned* ctl = (unsigned*)(ws + WS_CTL);
    volatile int* qslot = (volatile int*)(lds + LDS_BYTES - 64);
    LAS unsigned char* lds3 = (LAS unsigned char*)lds;
    if (p.ws == nullptr) grid.sync();
    volatile LAS unsigned* MISC = (volatile LAS unsigned*)(lds3 + LDS_BYTES - 128);
    if (tid0 < 16) MISC[tid0] = 0u;
    __syncthreads();
    XcdBarrier bar = xcd_barrier_post(ctl + CW_BAR, MISC + 8);
#define GSYNC() xcd_barrier(bar)

#ifndef REP_P0
#define REP_P0 1
#endif
    for (int rep = 0; rep < REP_P0; ++rep) {
    PHASE_IDS
#ifndef SKIP_P0
    p0_prologue(p, lds, tid, lane, wave);
#endif
    }
    GSYNC();
#ifndef REP_P1
#define REP_P1 1
#endif
    for (int rep = 0; rep < REP_P1; ++rep) {
    PHASE_IDS
#ifndef SKIP_P1
    p1_norm1(p, lds, tid, lane, wave);
#endif
    }
    GSYNC();
#ifndef REP_P2
#define REP_P2 1
#endif
    for (int rep = 0; rep < REP_P2; ++rep) {
    PHASE_IDS
#ifndef SKIP_G2
    { pg8::Gemm g{(const bf16_t*)(ws + WS_H), (const bf16_t*)(ws + WS_WIN), NTOK, PW, DM}; pg8::StaticOrder S; S.init(NTOK, PW, (int)gridDim.x, (int)blockIdx.x);
      pg8::EpiBf16<0> E{(bf16_t*)(ws + WS_P), PW, nullptr, 0, 0, 1.f};
      pg8::gemm_phase<pg8::EpiBf16<0>, pg8::StaticOrder, true, true>(lds3, g, S, E); }
#endif
    }
    GSYNC();
#ifndef REP_P3
#define REP_P3 1
#endif
    for (int rep = 0; rep < REP_P3; ++rep) {
    PHASE_IDS
    for (;;) { const int it = fetch_item(ctl + CW_Q3 + 4 * rep, qslot, tid); if (it >= 512 + 512 + 256) break;
#ifndef SKIP_WIN
        if (it < 512) { const int qblk = 31 - (it >> 4), bg = it & 15; nsa_window_unit(p, lds, bg >> 2, bg & 3, qblk, tid, lane, wave); } else
#endif
#ifndef SKIP_GLA
        if (it < 1024) gla_a_unit(p, lds, it - 512, tid, lane, wave); else
#endif
#ifndef SKIP_CMP
        if (it < 1280) nsa_compress_unit(p, lds, it - 1024, tid, lane, wave);
#endif
        ; }
    }
    GSYNC();
#ifndef REP_P3B
#define REP_P3B 1
#endif
    for (int rep = 0; rep < REP_P3B; ++rep) {
    PHASE_IDS
#ifndef SKIP_SCAN
    gla_scan(p, tid);
#endif
    }
    GSYNC();
#ifndef REP_P4
#define REP_P4 1
#endif
    for (int rep = 0; rep < REP_P4; ++rep) {
    PHASE_IDS
    for (;;) { const int it = fetch_item(ctl + CW_Q4 + 4 * rep, qslot, tid); if (it >= 1024) break;
#ifndef SKIP_SEL
        if (it < 512) { const int qblk = 31 - (it >> 4), bg = it & 15; nsa_cmp_sel_unit(p, lds, bg >> 2, bg & 3, qblk, tid, lane, wave); } else
#endif
#ifndef SKIP_GLC
        gla_c_unit(p, lds, it - 512, tid, lane, wave);
#endif
        ; }
    }
    GSYNC();
#ifndef REP_P5
#define REP_P5 1
#endif
    for (int rep = 0; rep < REP_P5; ++rep) {
    PHASE_IDS
#ifndef SKIP_G5
    { pg8::Gemm g{(const bf16_t*)(ws + WS_H), (const bf16_t*)(ws + WS_WOUT), NTOK, DM, DM}; pg8::StaticOrder S; S.init(NTOK, DM, (int)gridDim.x, (int)blockIdx.x);
      pg8::EpiResid E{p.in(0), p.out, (const float*)(ws + WS_MODF) + 4096};
      pg8::gemm_phase<pg8::EpiResid, pg8::StaticOrder, true, true>(lds3, g, S, E); }
#endif
    }
    GSYNC();
#ifndef SKIP_P6
    { PHASE_IDS p6_norm2_route(p, lds, tid, lane, wave); }
#endif
    GSYNC();
#ifndef REP_P7
#define REP_P7 1
#endif
    for (int rep = 0; rep < REP_P7; ++rep) {
    PHASE_IDS
#ifndef SKIP_P7
    p7_dispatch(p, lds, tid, lane, wave);
#endif
    }
    GSYNC();
    const int nrb = __hip_atomic_load((const int*)(ws + WS_RBE) + 128, __ATOMIC_RELAXED, __HIP_MEMORY_SCOPE_AGENT);
#ifndef REP_P8
#define REP_P8 1
#endif
    for (int rep = 0; rep < REP_P8; ++rep) {
    PHASE_IDS
#ifndef SKIP_G8
    { pg8::Gemm g{(const bf16_t*)(ws + WS_P), (const bf16_t*)(ws + WS_WGU), CAP, 32 * 1024, DM}; pg8::GroupedOrder S{(const int*)(ws + WS_RBE), nrb * 4, 4, (int)gridDim.x, (int)blockIdx.x};
      pg8::EpiSwiGLU E{(bf16_t*)(ws + WS_HMID)};
      pg8::gemm_phase<pg8::EpiSwiGLU, pg8::GroupedOrder, true, true>(lds3, g, S, E); }
#endif
    }
    GSYNC();
#ifndef REP_P9
#define REP_P9 1
#endif
    for (int rep = 0; rep < REP_P9; ++rep) {
    PHASE_IDS
#ifndef SKIP_G9
    { pg8::Gemm g{(const bf16_t*)(ws + WS_HMID), (const bf16_t*)(ws + WS_WD), CAP, 32 * 2048, 512}; pg8::GroupedOrder S{(const int*)(ws + WS_RBE), nrb * 8, 8, (int)gridDim.x, (int)blockIdx.x};
      pg8::EpiDown E{(bf16_t*)(ws + WS_P), (const int*)(ws + WS_SLOTT), (const float*)(ws + WS_SLOTW)};
      pg8::gemm_phase<pg8::EpiDown, pg8::GroupedOrder, true, true>(lds3, g, S, E); }
#endif
    }
    GSYNC();
#ifndef SKIP_P10
    { PHASE_IDS p10_final(p, tid, lane, wave); }
#endif
}

extern "C" void kernel_launch(void* const* d_in, const int* in_sizes, int n_in, void* d_out, int out_size, void* d_ws, size_t ws_size, hipStream_t stream) {
    static int grid_blocks = 0;
    if (!grid_blocks) {
        int dev = 0, cus = 0, per_cu = 0;
        (void)hipGetDevice(&dev);
        (void)hipDeviceGetAttribute(&cus, hipDeviceAttributeMultiprocessorCount, dev);
        (void)hipFuncSetAttribute((const void*)fwd_megakernel, hipFuncAttributeMaxDynamicSharedMemorySize, LDS_BYTES);
        (void)hipOccupancyMaxActiveBlocksPerMultiprocessor(&per_cu, (const void*)fwd_megakernel, NTHREADS, LDS_BYTES);
        if (per_cu < 1) fprintf(stderr, "kernel_launch: occupancy query reports %d blocks/CU\n", per_cu);
        grid_blocks = cus;
        if (ws_size < WS_END || n_in != 25) { fprintf(stderr, "kernel_launch: ws %zu < %zu or n_in %d != 25\n", ws_size, (size_t)WS_END, n_in); }
    }
    (void)hipMemsetAsync((char*)d_ws + WS_CTL, 0, CTL_ZERO_BYTES, stream);
    Params p{};
    for (int i = 0; i < 25; ++i) p.in[i] = (const float*)d_in[i];
    p.out = (float*)d_out; p.ws = (unsigned char*)d_ws;
    void* args[] = {&p};
    hipError_t e = hipLaunchCooperativeKernel((void*)fwd_megakernel, dim3(grid_blocks), dim3(NTHREADS), args, LDS_BYTES, stream);
    if (e != hipSuccess) fprintf(stderr, "cooperative launch failed: %s (grid %d)\n", hipGetErrorString(e), grid_blocks);
}
```

```cpp
#include <hip/hip_runtime.h>
#include <hip/hip_cooperative_groups.h>
#include <cstdio>
#include <cstdint>
namespace cg = cooperative_groups;
namespace pg8 {
#define PG8_LAS __attribute__((address_space(3)))
typedef unsigned short bf16_t;
typedef short bf16x8 __attribute__((ext_vector_type(8)));
typedef float f32x4 __attribute__((ext_vector_type(4)));
typedef unsigned u32x4 __attribute__((ext_vector_type(4)));
constexpr int BM = 256, BK = 64, HALF = 128, HTB = HALF * BK * 2  , STAGE_BYTES = 8 * HTB, NXCD = 8, WGM = 8;

__host__ __device__ __forceinline__ int lds_byte(int r, int c) { const int st = (r >> 4) * 2 + (c >> 5), rr = r & 15, cc = c & 31, ob = rr * 64 + cc * 2; return st * 1024 + (ob ^ (((ob >> 9) & 1) << 5)); }
__host__ __device__ __forceinline__ void stage_rc(int b, int& R, int& C) { const int st = b / 1024, sb = b % 1024, swz = sb ^ (((sb >> 9) & 1) << 5); R = (st >> 1) * 16 + swz / 64; C = (st & 1) * 32 + (swz % 64) / 2; }
__host__ __device__ __forceinline__ int perm32(int rho) { const int n = rho >> 4, i = rho & 15; return 8 * (i >> 2) + 4 * n + (i & 3); }

struct Unit { int pm, pn; };
struct Gemm { const bf16_t* A; const bf16_t* Bt; int M, N, K; };

struct StaticOrder {
    int nM, nN, nwg, G, c;
    __host__ __device__ void init(int M, int N, int G_, int c_) { nM = M / BM; nN = N / BM; nwg = nM * nN; G = G_; c = c_; }
    __host__ __device__ bool next(int i, Unit& u) const {
        const long L = (long)i * G + c; if (L >= nwg) return false;
        int wgid = (int)L; { const int q = nwg / NXCD, r = nwg % NXCD, xcd = wgid % NXCD, off = wgid / NXCD; wgid = (xcd < r ? xcd * (q + 1) : r * (q + 1) + (xcd - r) * q) + off; }
        const int nig = WGM * nN, gid = wgid / nig, fm = gid * WGM, gsz = (nM - fm) < WGM ? (nM - fm) : WGM;
        u.pm = fm + ((wgid % nig) % gsz); u.pn = (wgid % nig) / gsz; return true;
    }
    __device__ __forceinline__ void a_ready(const Unit&) const {}
    __device__ __forceinline__ void done(const Unit&) const {}
};

__device__ __forceinline__ unsigned cvt_pk_bf16(float lo, float hi) { unsigned r; asm volatile("v_cvt_pk_bf16_f32 %0, %1, %2" : "=v"(r) : "v"(lo), "v"(hi)); return r; }
typedef float f32x2 __attribute__((ext_vector_type(2)));
__device__ __forceinline__ f32x2 gelu_pk(f32x2 v) {
    const f32x2 av = __builtin_elementwise_abs(v), d = av * 0.2316418882f + 1.0f;
    f32x2 t; t.x = __builtin_amdgcn_rcpf(d.x); t.y = __builtin_amdgcn_rcpf(d.y);
    f32x2 q = t * 0.5307027145f + (-0.7265760135f); q = q * t + 0.7107068705f; q = q * t + (-0.142248368f); q = q * t + 0.127414796f; q = q * t;
    const f32x2 s = (v * v) * (-0.72134752044f);
    f32x2 e; e.x = __builtin_amdgcn_exp2f(s.x); e.y = __builtin_amdgcn_exp2f(s.y);
    const f32x2 m = v * (q * e), r = v - m;
    f32x2 o; o.x = v.x < 0.f ? m.x : r.x; o.y = v.y < 0.f ? m.y : r.y; return o;
}

template <int ACT  > struct EpiBf16 {
    static constexpr bool PERM = true, AFTER_DRAIN = false; static_assert(ACT == 0 || ACT == 1, "EpiBf16: ACT is 0 (none) or 1 (gelu_pk)");
    bf16_t* O; int ldc; const float* bias; int split_cols; size_t split_stride; float scale0;
    __device__ __forceinline__ void operator()(const f32x4 (&acc)[2][2][4][2], const Unit& u, int wr, int wc, int fr, int fq) const {
        const int row0 = u.pm * BM + wr * 64 + fr; int colt = u.pn * BM; bf16_t* base = O;
        float sc = 1.f; if (split_cols) { const int t = colt / split_cols; base += (size_t)t * split_stride; colt -= t * split_cols; if (t == 0) sc = scale0; }
        const int col0 = colt + wc * 32 + 8 * fq, bcol0 = u.pn * BM + wc * 32 + 8 * fq;
        f32x4 bv[2][2];
#pragma unroll
        for (int bj = 0; bj < 2; ++bj)
#pragma unroll
            for (int n = 0; n < 2; ++n) bv[bj][n] = bias ? *(const f32x4*)(bias + bcol0 + bj * HALF + 4 * n) : (f32x4){0.f, 0.f, 0.f, 0.f};
#pragma unroll
        for (int ai = 0; ai < 2; ++ai)
#pragma unroll
            for (int m = 0; m < 4; ++m) { bf16_t* rowp = base + (size_t)(row0 + ai * HALF + m * 16) * ldc + col0;
#pragma unroll
                for (int bj = 0; bj < 2; ++bj) { f32x4 v0 = acc[ai][bj][m][0] + bv[bj][0], v1 = acc[ai][bj][m][1] + bv[bj][1];
                    if (ACT == 1) { f32x2 a = gelu_pk((f32x2){v0[0], v0[1]}), b = gelu_pk((f32x2){v0[2], v0[3]}), c = gelu_pk((f32x2){v1[0], v1[1]}), d = gelu_pk((f32x2){v1[2], v1[3]});
                        v0 = (f32x4){a.x, a.y, b.x, b.y}; v1 = (f32x4){c.x, c.y, d.x, d.y}; }
                    v0 = v0 * sc; v1 = v1 * sc; u32x4 w; w.x = cvt_pk_bf16(v0[0], v0[1]); w.y = cvt_pk_bf16(v0[2], v0[3]); w.z = cvt_pk_bf16(v1[0], v1[1]); w.w = cvt_pk_bf16(v1[2], v1[3]);
                    *(u32x4*)(rowp + bj * HALF) = w; } }
    }
};
template <class Epi, class Sched, bool ALIGN_EPI = false, bool SP2 = false>
__device__ __forceinline__ void gemm_phase(PG8_LAS unsigned char* lds, const Gemm g, const Sched& S, const Epi& E) {
    int tid_ = threadIdx.x; asm volatile("" : "+v"(tid_));
    const int tid = tid_, wid = __builtin_amdgcn_readfirstlane(tid >> 6), lane = tid & 63, wr = wid >> 2, wc = wid & 3, fr = lane & 15, fq = lane >> 4;
    const int K = g.K, nt = K / BK;
    unsigned voffA[2], voffB[2];
#pragma unroll
    for (int i = 0; i < 2; ++i) { int R, C; stage_rc(tid * 16 + i * 8192, R, C); const int Rb = Epi::PERM ? ((R & ~31) + perm32(R & 31)) : R;
        voffA[i] = (unsigned)(R * K + C) * 2u; voffB[i] = (unsigned)(Rb * K + C) * 2u; }
    const size_t kstep = (size_t)(BK * 2);
    const size_t hstep = (size_t)HALF * K * 2;
    const size_t tstep = 2 * hstep;
    const unsigned ldsw = (unsigned)wid * 1024u;
    const int aoff = lds_byte(wr * 64 + fr, fq * 8), boff = lds_byte(wc * 32 + fr, fq * 8);
#define PG8_SA(b, h) (((b) * 2 + (h)) * HTB)
#define PG8_SB(b, h) ((4 + (b) * 2 + (h)) * HTB)
#define PG8_STAGE(bufoff, gbase, voff) do { _Pragma("unroll") for (int _i = 0; _i < 2; ++_i) \
        __builtin_amdgcn_global_load_lds((const unsigned*)((const char*)(gbase) + (voff)[_i]), (PG8_LAS unsigned*)(lds + (bufoff) + ldsw + _i * 8192), 16, 0, 0); } while (0)
#define PG8_LDA(dst, b, h) do { _Pragma("unroll") for (int m = 0; m < 4; ++m) _Pragma("unroll") for (int k = 0; k < 2; ++k) dst[m][k] = *(const PG8_LAS bf16x8*)(lds + PG8_SA(b, h) + aoff + m * 2048 + k * 1024); } while (0)
#define PG8_LDB(dst, b, h) do { _Pragma("unroll") for (int n = 0; n < 2; ++n) _Pragma("unroll") for (int k = 0; k < 2; ++k) dst[n][k] = *(const PG8_LAS bf16x8*)(lds + PG8_SB(b, h) + boff + n * 2048 + k * 1024); } while (0)
#define PG8_MMA(ai, bj, At, Bt) do { __builtin_amdgcn_s_setprio(1); _Pragma("unroll") for (int m = 0; m < 4; ++m) _Pragma("unroll") for (int n = 0; n < 2; ++n) _Pragma("unroll") for (int k = 0; k < 2; ++k) \
        acc[ai][bj][m][n] = __builtin_amdgcn_mfma_f32_16x16x32_bf16(Bt[n][k], At[m][k], acc[ai][bj][m][n], 0, 0, 0); __builtin_amdgcn_s_setprio(0); } while (0)
#define PG8_WAIT_V(n) asm volatile("s_waitcnt vmcnt(" #n ")" ::: "memory")
#define PG8_WAIT_L(n) asm volatile("s_waitcnt lgkmcnt(" #n ")" ::: "memory")
#define PG8_BAR __builtin_amdgcn_s_barrier()
#define PG8_SCHED __builtin_amdgcn_sched_barrier(0)
    Unit cur, nxt; int ui = 0;
    if (!S.next(0, cur)) return;
    f32x4 acc[2][2][4][2];
#pragma unroll
    for (int a = 0; a < 2; ++a)
#pragma unroll
        for (int b = 0; b < 2; ++b)
#pragma unroll
            for (int m = 0; m < 4; ++m)
#pragma unroll
                for (int n = 0; n < 2; ++n) acc[a][b][m][n] = (f32x4){0.f, 0.f, 0.f, 0.f};
    bf16x8 At[4][2], B0[2][2], B1[2][2];
    const char* cA = (const char*)g.A + (size_t)cur.pm * tstep; const char* cB = (const char*)g.Bt + (size_t)cur.pn * tstep;
    S.a_ready(cur);
    if constexpr (SP2) {
        PG8_STAGE(PG8_SB(0, 0), cB, voffB); PG8_STAGE(PG8_SB(0, 1), cB + hstep, voffB); PG8_STAGE(PG8_SA(0, 0), cA, voffA); PG8_STAGE(PG8_SA(0, 1), cA + hstep, voffA);
        if (wr == 1) PG8_BAR;
        PG8_WAIT_V(2); PG8_BAR;
        PG8_STAGE(PG8_SB(1, 0), cB + kstep, voffB); PG8_STAGE(PG8_SA(1, 0), cA + kstep, voffA); PG8_STAGE(PG8_SB(1, 1), cB + hstep + kstep, voffB);
        PG8_WAIT_V(6); PG8_BAR;
    } else {
        PG8_STAGE(PG8_SB(0, 0), cB, voffB); PG8_STAGE(PG8_SA(0, 0), cA, voffA); PG8_STAGE(PG8_SB(0, 1), cB + hstep, voffB); PG8_STAGE(PG8_SA(0, 1), cA + hstep, voffA);
        if (wr == 1) PG8_BAR;
        PG8_WAIT_V(4); PG8_BAR;
        PG8_STAGE(PG8_SB(1, 0), cB + kstep, voffB); PG8_STAGE(PG8_SA(1, 0), cA + kstep, voffA); PG8_STAGE(PG8_SB(1, 1), cB + hstep + kstep, voffB);
        PG8_WAIT_V(6); PG8_BAR;
    }
    for (;;) {
        const bool has_next = S.next(ui + 1, nxt);
        const char* nA = has_next ? (const char*)g.A + (size_t)nxt.pm * tstep : cA; const char* nB = has_next ? (const char*)g.Bt + (size_t)nxt.pn * tstep : cB;
        for (int t = 0; t < nt; t += 2) {
            const bool last = (t == nt - 2);
            const char* a1 = cA + (size_t)(t + 1) * kstep;
            const char* a2 = last ? nA : cA + (size_t)(t + 2) * kstep; const char* b2 = last ? nB : cB + (size_t)(t + 2) * kstep;
            const char* a3 = a2 + kstep; const char* b3 = b2 + kstep;
            if (last && has_next) S.a_ready(nxt);
            if constexpr (SP2) {
            PG8_LDB(B0, 0, 0); PG8_LDB(B1, 0, 1); PG8_SCHED; PG8_LDA(At, 0, 0); PG8_STAGE(PG8_SA(1, 1), a1 + hstep, voffA);
            PG8_WAIT_V(8); PG8_WAIT_L(0); PG8_BAR; PG8_MMA(0, 0, At, B0); PG8_MMA(0, 1, At, B1); PG8_BAR; PG8_SCHED;
            PG8_LDA(At, 0, 1); PG8_STAGE(PG8_SB(0, 0), b2, voffB); PG8_STAGE(PG8_SB(0, 1), b2 + hstep, voffB); PG8_STAGE(PG8_SA(0, 0), a2, voffA);
            PG8_WAIT_V(8); PG8_WAIT_L(0); PG8_BAR; PG8_MMA(1, 0, At, B0); PG8_MMA(1, 1, At, B1); PG8_BAR; PG8_SCHED;
            PG8_LDB(B0, 1, 0); PG8_LDB(B1, 1, 1); PG8_SCHED; PG8_LDA(At, 1, 0); PG8_STAGE(PG8_SA(0, 1), a2 + hstep, voffA);
            PG8_WAIT_V(8); PG8_WAIT_L(0); PG8_BAR; PG8_MMA(0, 0, At, B0); PG8_MMA(0, 1, At, B1); PG8_BAR; PG8_SCHED;
            PG8_LDA(At, 1, 1); PG8_STAGE(PG8_SB(1, 0), b3, voffB); PG8_STAGE(PG8_SB(1, 1), b3 + hstep, voffB); PG8_STAGE(PG8_SA(1, 0), a3, voffA);
            PG8_WAIT_V(8); PG8_WAIT_L(0); PG8_BAR; PG8_MMA(1, 0, At, B0); PG8_MMA(1, 1, At, B1); PG8_BAR; PG8_SCHED;
            } else {
            PG8_LDB(B0, 0, 0); PG8_SCHED; PG8_LDA(At, 0, 0); PG8_STAGE(PG8_SA(1, 1), a1 + hstep, voffA);
            PG8_WAIT_L(8); PG8_BAR; PG8_WAIT_L(0); PG8_MMA(0, 0, At, B0); PG8_BAR; PG8_SCHED;
            PG8_LDB(B1, 0, 1); PG8_STAGE(PG8_SB(0, 0), b2, voffB);
            PG8_BAR; PG8_WAIT_L(0); PG8_MMA(0, 1, At, B1); PG8_BAR;
            PG8_LDA(At, 0, 1); PG8_STAGE(PG8_SA(0, 0), a2, voffA);
            PG8_BAR; PG8_WAIT_L(0); PG8_MMA(1, 0, At, B0); PG8_BAR; PG8_SCHED;
            PG8_STAGE(PG8_SB(0, 1), b2 + hstep, voffB);
            PG8_WAIT_V(6); PG8_BAR; PG8_MMA(1, 1, At, B1); PG8_BAR;
            PG8_LDB(B0, 1, 0); PG8_SCHED; PG8_LDA(At, 1, 0); PG8_STAGE(PG8_SA(0, 1), a2 + hstep, voffA);
            PG8_WAIT_L(8); PG8_BAR; PG8_WAIT_L(0); PG8_MMA(0, 0, At, B0); PG8_BAR; PG8_SCHED;
            PG8_LDB(B1, 1, 1); PG8_STAGE(PG8_SB(1, 0), b3, voffB);
            PG8_BAR; PG8_WAIT_L(0); PG8_MMA(0, 1, At, B1); PG8_BAR;
            PG8_LDA(At, 1, 1); PG8_STAGE(PG8_SA(1, 0), a3, voffA);
            PG8_BAR; PG8_WAIT_L(0); PG8_MMA(1, 0, At, B0); PG8_BAR; PG8_SCHED;
            PG8_STAGE(PG8_SB(1, 1), b3 + hstep, voffB);
            PG8_WAIT_V(6); PG8_BAR; PG8_MMA(1, 1, At, B1); PG8_BAR;
            }
        }
        if constexpr (ALIGN_EPI) { if (wr == 0) PG8_BAR; }
        if constexpr (!Epi::AFTER_DRAIN) { E(acc, cur, wr, wc, fr, fq); S.done(cur); }
        if (!has_next) break;
#pragma unroll
        for (int a = 0; a < 2; ++a)
#pragma unroll
            for (int b = 0; b < 2; ++b)
#pragma unroll
                for (int m = 0; m < 4; ++m)
#pragma unroll
                    for (int n = 0; n < 2; ++n) acc[a][b][m][n] = (f32x4){0.f, 0.f, 0.f, 0.f};
        cur = nxt; cA = nA; cB = nB; ++ui;
        if constexpr (ALIGN_EPI) { if (wr == 1) PG8_BAR; }
    }
    PG8_WAIT_V(0);
    if constexpr (!ALIGN_EPI) { if (wr == 0) PG8_BAR; }
    PG8_BAR;
    if constexpr (Epi::AFTER_DRAIN) { E.fused(acc, cur, wr, wc, fr, fq, lds, wid, lane); S.done(cur); }
#undef PG8_SA
#undef PG8_SB
#undef PG8_STAGE
#undef PG8_LDA
#undef PG8_LDB
#undef PG8_MMA
#undef PG8_WAIT_V
#undef PG8_WAIT_L
#undef PG8_BAR
#undef PG8_SCHED
}
}

namespace pg8 {
__device__ __forceinline__ float silu_f(float x) { return x * __builtin_amdgcn_rcpf(1.0f + __builtin_amdgcn_exp2f(-1.4426950408889634f * x)); }
struct EpiResid {
    static constexpr bool PERM = true, AFTER_DRAIN = false;
    const float* X; float* O; const float* G;
    float* SSQP;
    __device__ __forceinline__ void operator()(const f32x4 (&acc)[2][2][4][2], const Unit& u, int wr, int wc, int fr, int fq) const {
        const int row0 = u.pm * BM + wr * 64 + fr, col0 = u.pn * BM + wc * 32 + 8 * fq;
        const int b = (u.pm * BM) >> 11;
        const float* gp = G + (size_t)b * 12288 + col0;
        f32x4 gv[2][2];
#pragma unroll
        for (int bj = 0; bj < 2; ++bj)
#pragma unroll
            for (int n = 0; n < 2; ++n) gv[bj][n] = *(const f32x4*)(gp + bj * HALF + 4 * n);
#pragma unroll
        for (int ai = 0; ai < 2; ++ai)
#pragma unroll
            for (int m = 0; m < 4; ++m) { const size_t off = (size_t)(row0 + ai * HALF + m * 16) * 2048 + col0; float sq = 0.f;
#pragma unroll
                for (int bj = 0; bj < 2; ++bj)
#pragma unroll
                    for (int n = 0; n < 2; ++n) { const f32x4 xv = *(const f32x4*)(X + off + bj * HALF + 4 * n); const f32x4 o = xv + gv[bj][n] * acc[ai][bj][m][n]; *(f32x4*)(O + off + bj * HALF + 4 * n) = o;
                        sq += (o[0] * o[0] + o[1] * o[1]) + (o[2] * o[2] + o[3] * o[3]); }
                sq += __shfl_xor(sq, 16); sq += __shfl_xor(sq, 32);
                if (fq == 0) SSQP[(size_t)(row0 + ai * HALF + m * 16) * 32 + u.pn * 4 + wc] = sq; }
    }
};
struct EpiSwiGLU {
    static constexpr bool PERM = true, AFTER_DRAIN = false;
    bf16_t* Hm;
    __device__ __forceinline__ void operator()(const f32x4 (&acc)[2][2][4][2], const Unit& u, int wr, int wc, int fr, int fq) const {
        const int t = u.pn & 3; const int row0 = u.pm * BM + wr * 64 + fr, col0 = t * 128 + wc * 32 + 8 * fq;
#pragma unroll
        for (int ai = 0; ai < 2; ++ai)
#pragma unroll
            for (int m = 0; m < 4; ++m) { bf16_t* rowp = Hm + (size_t)(row0 + ai * HALF + m * 16) * 512 + col0;
                const f32x4 g0 = acc[ai][0][m][0], g1 = acc[ai][0][m][1], u0 = acc[ai][1][m][0], u1 = acc[ai][1][m][1];
                u32x4 w; w.x = cvt_pk_bf16(silu_f(g0[0]) * u0[0], silu_f(g0[1]) * u0[1]); w.y = cvt_pk_bf16(silu_f(g0[2]) * u0[2], silu_f(g0[3]) * u0[3]);
                w.z = cvt_pk_bf16(silu_f(g1[0]) * u1[0], silu_f(g1[1]) * u1[1]); w.w = cvt_pk_bf16(silu_f(g1[2]) * u1[2], silu_f(g1[3]) * u1[3]);
                *(u32x4*)rowp = w; }
    }
};
struct EpiDown {
    static constexpr bool PERM = true, AFTER_DRAIN = false;
    bf16_t* Y; const int* slot_tok; const float* slot_w;
    __device__ __forceinline__ void operator()(const f32x4 (&acc)[2][2][4][2], const Unit& u, int wr, int wc, int fr, int fq) const {
        const int t = u.pn & 7; const int row0 = u.pm * BM + wr * 64 + fr, col0 = t * 256 + wc * 32 + 8 * fq;
#pragma unroll
        for (int ai = 0; ai < 2; ++ai)
#pragma unroll
            for (int m = 0; m < 4; ++m) { const int slot = row0 + ai * HALF + m * 16; const int st = slot_tok[slot];
                if (st >= 0) { const float w = slot_w[slot]; bf16_t* rowp = Y + (size_t)st * 2048 + col0;
#pragma unroll
                    for (int bj = 0; bj < 2; ++bj) { const f32x4 v0 = acc[ai][bj][m][0] * w, v1 = acc[ai][bj][m][1] * w;
                        u32x4 o; o.x = cvt_pk_bf16(v0[0], v0[1]); o.y = cvt_pk_bf16(v0[2], v0[3]); o.z = cvt_pk_bf16(v1[0], v1[1]); o.w = cvt_pk_bf16(v1[2], v1[3]);
                        *(u32x4*)(rowp + bj * HALF) = o; } } }
    }
};
struct GroupedOrder {
    const int* rbe; int nunits, NT, G, c;
    __device__ __forceinline__ bool next(int i, Unit& u) const {
        const long L = (long)i * G + c; if (L >= nunits) return false;
        const int rb = (int)(L / NT), t = (int)(L % NT);
        const int e = __hip_atomic_load(rbe + rb, __ATOMIC_RELAXED, __HIP_MEMORY_SCOPE_AGENT);
        u.pm = rb; u.pn = e * NT + t; return true;
    }
    __device__ __forceinline__ void a_ready(const Unit&) const {}
    __device__ __forceinline__ void done(const Unit&) const {}
};
}

using pg8::bf16_t; using pg8::bf16x8; using pg8::f32x4; using pg8::u32x4;
typedef float f32x16 __attribute__((ext_vector_type(16)));
typedef short s16x4 __attribute__((ext_vector_type(4)));
typedef unsigned u32x2 __attribute__((ext_vector_type(2)));
#define LAS __attribute__((address_space(3)))

constexpr int NTHREADS = 512, NWAVES = 8;
constexpr int LDS_BYTES = 147456;
constexpr int DM = 2048, NTOK = 8192, SEQ = 2048, NB = 4;
constexpr int PW = 5888;
constexpr int PC_Q = 0, PC_KC = 1024, PC_VC = 1280, PC_KS = 1536, PC_VS = 1792, PC_KW = 2048, PC_VW = 2304;
constexpr int PC_GQ = 2560, PC_GK = 3072, PC_GV = 3584, PC_GO = 4608, PC_GATE = 5632, PC_LR = 5680;
constexpr int NKC = 16;
constexpr int CAP = 24576;
constexpr float LOG2E = 1.4426950408889634f;
constexpr float EPS = 1e-6f;

constexpr size_t MiB = 1u << 20;
constexpr size_t WS_CTL = 0, CTL_ZERO_BYTES = 64 * 1024;
constexpr size_t WS_MODP = 1 * MiB;
constexpr size_t WS_MODF = 5 * MiB;
constexpr size_t WS_A2G = WS_MODF + 256 * 1024;
constexpr size_t WS_SH2G = WS_A2G + 64 * 1024;
constexpr size_t WS_SMALL = 6 * MiB;
constexpr size_t WS_W1TK = WS_SMALL;
constexpr size_t WS_W1TV = WS_W1TK + 256 * 1024;
constexpr size_t WS_W2TK = WS_W1TV + 256 * 1024;
constexpr size_t WS_W2TV = WS_W2TK + 8 * 1024;
constexpr size_t WS_POSW1 = WS_W2TV + 8 * 1024;
constexpr size_t WS_KC = WS_POSW1 + 4 * 1024;
constexpr size_t WS_VCT = WS_KC + 256 * 1024;
constexpr size_t WS_WRH = WS_VCT + 256 * 1024;
constexpr size_t WS_WRL = WS_WRH + 192 * 1024;
constexpr size_t WS_ROUTE = 8 * MiB;
constexpr size_t WS_TOKE = WS_ROUTE;
constexpr size_t WS_TOKW = WS_TOKE + 64 * 1024;
constexpr size_t WS_TOKP = WS_TOKW + 64 * 1024;
constexpr size_t WS_SLOTT = WS_TOKP + 64 * 1024;
constexpr size_t WS_SLOTW = WS_SLOTT + 128 * 1024;
constexpr size_t WS_RBE = WS_SLOTW + 128 * 1024;
constexpr size_t WS_WIN = 10 * MiB;
constexpr size_t WS_WOUT = 33 * MiB;
constexpr size_t WS_WGU = 41 * MiB;
constexpr size_t WS_WD = 169 * MiB;
constexpr size_t WS_H = 233 * MiB;
constexpr size_t WS_P = 265 * MiB;
constexpr size_t WS_OW = 361 * MiB;
constexpr size_t WS_HMID = 377 * MiB;
constexpr size_t WS_GQT = 401 * MiB;
constexpr size_t WS_GOI = 409 * MiB;
constexpr size_t WS_GDS = 425 * MiB;
constexpr size_t WS_GSS = 457 * MiB;
constexpr size_t WS_GDEC = 489 * MiB;
constexpr size_t WS_SSQP = 490 * MiB;
constexpr size_t WS_END = 491 * MiB;
constexpr int CW_Q3 = 64, CW_Q4 = 128, CW_ECNT = 256, CW_BAR = 4096;

struct Params { const float* in[25]; float* out; unsigned char* ws; };
struct KP { volatile __attribute__((address_space(3))) unsigned long long* tab; float* out; unsigned char* ws;
    __device__ __forceinline__ const float* in(int i) const { const unsigned long long v = tab[i];
        const unsigned lo = __builtin_amdgcn_readfirstlane((unsigned)v), hi = __builtin_amdgcn_readfirstlane((unsigned)(v >> 32));
        return (const float*)(((unsigned long long)hi << 32) | lo); } };

__device__ __forceinline__ float bf2f(unsigned short v) { return __uint_as_float((unsigned)v << 16); }
__device__ __forceinline__ unsigned pk2(float lo, float hi) {
    typedef float f2_t __attribute__((ext_vector_type(2))); typedef __bf16 b2_t __attribute__((ext_vector_type(2)));
    f2_t v = {lo, hi}; b2_t b = __builtin_convertvector(v, b2_t); return __builtin_bit_cast(unsigned, b);
}
__device__ __forceinline__ unsigned short f2bf(float f) { return (unsigned short)(pk2(f, 0.f) & 0xffffu); }
__device__ __forceinline__ float wave_sum(float v) {
#pragma unroll
    for (int o = 1; o < 64; o <<= 1) v += __shfl_xor(v, o);
    return v;
}
__device__ __forceinline__ float fexp2(float x) { return __builtin_amdgcn_exp2f(x); }
__device__ __forceinline__ float fexp(float x) { return __builtin_amdgcn_exp2f(x * LOG2E); }
__device__ __forceinline__ float sigmoid_f(float x) { return __builtin_amdgcn_rcpf(1.0f + fexp(-x)); }
__device__ __forceinline__ f32x16 mfma32(bf16x8 a, bf16x8 b, f32x16 c) { return __builtin_amdgcn_mfma_f32_32x32x16_bf16(a, b, c, 0, 0, 0); }
__device__ __forceinline__ f32x4 mfma16(bf16x8 a, bf16x8 b, f32x4 c) { return __builtin_amdgcn_mfma_f32_16x16x32_bf16(a, b, c, 0, 0, 0); }
__device__ __forceinline__ bf16x8 cat4(s16x4 a, s16x4 b) { return (bf16x8){a[0], a[1], a[2], a[3], b[0], b[1], b[2], b[3]}; }

template <class Map>
__device__ __forceinline__ void tr_item(const float* __restrict__ W, int K, int N, int k0, int n0, bf16_t* WT, const Map& map, float* scr, int lane) {
    f32x4 v[16];
    const float* src = W + (size_t)(k0 + (lane >> 4)) * N + n0 + (lane & 15) * 4;
#pragma unroll
    for (int i = 0; i < 16; ++i) v[i] = *(const f32x4*)(src + (size_t)(4 * i) * N);
#pragma unroll
    for (int i = 0; i < 16; ++i) { float* d = scr + (4 * i + (lane >> 4)) * 65 + (lane & 15) * 4; d[0] = v[i].x; d[1] = v[i].y; d[2] = v[i].z; d[3] = v[i].w; }
    asm volatile("s_waitcnt lgkmcnt(0)" ::: "memory");
    const int c = lane & 7;
#pragma unroll
    for (int j = 0; j < 8; ++j) { const int n = (lane >> 3) + 8 * j; const float* s = scr + (8 * c) * 65 + n; const int row = map(n0 + n);
        u32x4 o; o.x = pk2(s[0 * 65], s[1 * 65]); o.y = pk2(s[2 * 65], s[3 * 65]); o.z = pk2(s[4 * 65], s[5 * 65]); o.w = pk2(s[6 * 65], s[7 * 65]);
        if (row >= 0) *(u32x4*)(WT + (size_t)row * K + k0 + 8 * c) = o; }
    asm volatile("s_waitcnt lgkmcnt(0)" ::: "memory");
}
struct MapIn { __device__ __forceinline__ int operator()(int oc) const {
    if (oc < 2560) return oc; if (oc < 2608) return oc - 2560 + PC_GATE; if (oc < 5680) return oc - 48; return oc; } };
struct MapOff { int off; __device__ __forceinline__ int operator()(int n) const { return off + n; } };
struct MapGU { int base; __device__ __forceinline__ int operator()(int n) const { return base + (n >> 7) * 256 + (n & 127); } };

__device__ __forceinline__ void p0_prologue(const KP& p, unsigned char* lds, int tid, int lane, int wave) {
    const int G = gridDim.x, gw = blockIdx.x * NWAVES + wave, NGW = G * NWAVES;
    unsigned char* ws = p.ws;
    float* scr = (float*)(lds + wave * 16640);
    float* SC = (float*)lds;
    constexpr int nGEMV = NKC * 48, nTin = 32 * 89, nTout = 32 * 32, nTg = 32 * 32 * 8, nTd = 32 * 8 * 32, nTc1 = 32, nTc2 = 1, nZero = 192, nPos = 2;
    constexpr int nTrans = nTin + 2 * nTc1 + 2 * nTc2 + nZero + nPos;
    (void)nTout; (void)nTg; (void)nTd;
    __syncthreads();
    for (int i = tid; i < 4 * 2048; i += NTHREADS) { const float v = p.in(1)[i]; SC[i] = v * sigmoid_f(v); }
    __syncthreads();
    for (int r = gw; r < nGEMV; r += NGW) {
        const int cgp = r % 48, kc = r / 48; const int col = cgp * 256 + lane * 4; const float* W = p.in(2) + (size_t)(kc * 128) * 12288 + col;
        f32x4 a0 = {0, 0, 0, 0}, a1 = a0, a2 = a0, a3 = a0;
#pragma unroll 16
        for (int kk = 0; kk < 128; ++kk) { const f32x4 w = *(const f32x4*)(W + (size_t)kk * 12288); const int k = kc * 128 + kk;
            a0 += w * SC[k]; a1 += w * SC[2048 + k]; a2 += w * SC[4096 + k]; a3 += w * SC[6144 + k]; }
        float* mp = (float*)(ws + WS_MODP) + (size_t)kc * 4 * 12288 + col;
        *(f32x4*)(mp) = a0; *(f32x4*)(mp + 12288) = a1; *(f32x4*)(mp + 2 * 12288) = a2; *(f32x4*)(mp + 3 * 12288) = a3; }
    __syncthreads();
    for (int it = gw; it < nTrans; it += NGW) {
        int r = it;
        if (r < nTin) { const int kb = r / 89, nb = r % 89; tr_item(p.in(5), 2048, 5696, 64 * kb, 64 * nb, (bf16_t*)(ws + WS_WIN), MapIn{}, scr, lane); continue; }
        r -= nTin;
        if (r < 2 * nTc1) { const int v = r / nTc1, kb = r % nTc1;
            tr_item(p.in(v ? 10 : 7), 2048, 64, 64 * kb, 0, (bf16_t*)(ws + (v ? WS_W1TV : WS_W1TK)), MapOff{0}, scr, lane); continue; }
        r -= 2 * nTc1;
        if (r < 2 * nTc2) { const int v = r;
            tr_item(p.in(v ? 11 : 8), 64, 64, 0, 0, (bf16_t*)(ws + (v ? WS_W2TV : WS_W2TK)), MapOff{0}, scr, lane); continue; }
        r -= 2 * nTc2;
        if (r < nZero) { u32x4* z = (u32x4*)((bf16_t*)(ws + WS_WIN) + (size_t)(5696 + r) * 2048);
#pragma unroll
            for (int j = 0; j < 4; ++j) z[lane + 64 * j] = (u32x4){0u, 0u, 0u, 0u};
            continue; }
        r -= nZero;
        {
            const int v = r; const float* pos = p.in(v ? 9 : 6); const float* w1 = p.in(v ? 10 : 7); float s = 0.f;
            for (int k = 0; k < 2048; ++k) s += pos[k] * w1[(size_t)k * 64 + lane];
            ((float*)(ws + WS_POSW1))[v * 64 + lane] = s; }
    }
    { bf16_t* WH = (bf16_t*)(ws + WS_WRH); bf16_t* WL = (bf16_t*)(ws + WS_WRL);
      for (int idx = blockIdx.x * NTHREADS + tid; idx < 48 * 2048; idx += G * NTHREADS) { const int n = idx >> 11, k = idx & 2047;
          float w = 0.f; if (n < 32) w = p.in(19)[(size_t)k * 32 + n]; else if (n < 36) w = p.in(17)[(size_t)k * 4 + (n - 32)];
          const unsigned short h = f2bf(w); WH[idx] = h; WL[idx] = f2bf(w - bf2f(h)); } }
}

constexpr int CONV_WITEMS = 2 * 32 * 32 * 8 + 32 * 8 * 32 + 32 * 32;
constexpr int CONV_BITEMS = CONV_WITEMS / 64;
__device__ __forceinline__ void conv_block_item(const KP& p, unsigned char* lds, int ci, int lane, int wave) {
    unsigned char* ws = p.ws; float* scr = (float*)(lds + wave * 16640);
    constexpr int nTg = 32 * 32 * 8, nTd = 32 * 8 * 32;
#pragma unroll 1
    for (int q8 = 0; q8 < 8; ++q8) { int r = ci * 64 + q8 * 8 + wave;
        if (r < 2 * nTg) { const int up = r / nTg; r -= up * nTg; const int e = r / 256, q = r % 256, kb = q / 8, nb = q % 8;
            tr_item(p.in(21 + up) + (size_t)e * 2048 * 512, 2048, 512, 64 * kb, 64 * nb, (bf16_t*)(ws + WS_WGU), MapGU{e * 1024 + up * 128}, scr, lane); continue; }
        r -= 2 * nTg;
        if (r < nTd) { const int e = r / 256, q = r % 256, kb = q / 32, nb = q % 32;
            tr_item(p.in(23) + (size_t)e * 512 * 2048, 512, 2048, 64 * kb, 64 * nb, (bf16_t*)(ws + WS_WD), MapOff{e * 2048}, scr, lane); continue; }
        r -= nTd;
        { const int kb = r / 32, nb = r % 32; tr_item(p.in(15), 2048, 2048, 64 * kb, 64 * nb, (bf16_t*)(ws + WS_WOUT), MapOff{0}, scr, lane); } }
}

__device__ __forceinline__ void p1_norm1(const KP& p, unsigned char* lds, int tid, int lane, int wave) {
    unsigned char* ws = p.ws; const float* MODP = (const float*)(ws + WS_MODP); const float* bada = p.in(3);
    float* A1 = (float*)lds; float* SH1 = A1 + 2048;
    for (int rbk = blockIdx.x; rbk < 256; rbk += gridDim.x) {
        const int b = rbk >> 6;
        __syncthreads();
        for (int k = tid; k < 2048; k += NTHREADS) { float sh = bada[k], sc = bada[2048 + k];
            for (int kc = 0; kc < NKC; ++kc) { const float* mp = MODP + ((size_t)kc * 4 + b) * 12288; sh += mp[k]; sc += mp[2048 + k]; }
            A1[k] = p.in(4)[k] * (1.0f + sc); SH1[k] = sh; }
        if (tid < 192) { const int idx = rbk * 192 + tid; const int bb = idx / 12288, j = idx % 12288; float s = bada[j];
            for (int kc = 0; kc < NKC; ++kc) s += MODP[((size_t)kc * 4 + bb) * 12288 + j];
            ((float*)(ws + WS_MODF))[idx] = s;
            if (j >= 6144 && j < 8192) ((float*)(ws + WS_SH2G))[bb * 2048 + (j - 6144)] = s;
            if (j >= 8192 && j < 10240) ((float*)(ws + WS_A2G))[bb * 2048 + (j - 8192)] = p.in(16)[j - 8192] * (1.0f + s); }
        __syncthreads();
        for (int i = 0; i < 4; ++i) { const int row = rbk * 32 + wave * 4 + i; const f32x4* xr = (const f32x4*)(p.in(0) + (size_t)row * DM) + lane;
            f32x4 v[8]; float s = 0.f;
#pragma unroll
            for (int j = 0; j < 8; ++j) { v[j] = xr[64 * j]; s += (v[j].x * v[j].x + v[j].y * v[j].y) + (v[j].z * v[j].z + v[j].w * v[j].w); }
            const float rstd = rsqrtf(wave_sum(s) * (1.0f / DM) + EPS);
            u32x2* o = (u32x2*)((bf16_t*)(ws + WS_H) + (size_t)row * DM) + lane;
#pragma unroll
            for (int j = 0; j < 8; ++j) { const int k = 4 * lane + 256 * j; const f32x4 a = *(const f32x4*)(A1 + k), sh = *(const f32x4*)(SH1 + k);
                const f32x4 h = v[j] * rstd * a + sh; u32x2 w; w.x = pk2(h.x, h.y); w.y = pk2(h.z, h.w); o[64 * j] = w; } }
    }
}

__device__ __forceinline__ int fetch_item(unsigned* ctr, volatile int* slot, int tid) {
    __syncthreads();
    if (tid == 0) *slot = (int)atomicAdd(ctr, 1u);
    __syncthreads();
    return *slot;
}
__device__ __forceinline__ int fetch_issue(unsigned* ctr, int tid) { return tid == 0 ? (int)atomicAdd(ctr, 1u) : 0; }
__device__ __forceinline__ int fetch_publish(int nxt, volatile int* slot, int tid) {
    __syncthreads();
    if (tid == 0) *slot = nxt;
    __syncthreads();
    return *slot;
}

constexpr int KSTR = 72;
constexpr int TILE_EL = 64 * KSTR;
constexpr float ATT_C1 = 0.125f * LOG2E;
typedef short v4i16_t __attribute__((ext_vector_type(4)));
__device__ __forceinline__ s16x4 vtr(const bf16_t* q) { return __builtin_bit_cast(s16x4, __builtin_amdgcn_ds_read_tr16_b64_v4i16((LAS v4i16_t*)q)); }

__device__ __forceinline__ void pv_acc(const bf16_t* Vs, int kvo, const f32x16& pt, int lane, f32x16& o0, f32x16& o1) {
    const int l15 = lane & 15, g1 = (lane >> 4) & 1, hi = lane >> 5;
    const bf16_t* vb = Vs + (kvo + 4 * hi + (l15 >> 2)) * KSTR + 16 * g1 + 4 * (l15 & 3);
#pragma unroll
    for (int s = 0; s < 2; ++s) {
        u32x4 pw; pw.x = pk2(pt[8 * s + 0], pt[8 * s + 1]); pw.y = pk2(pt[8 * s + 2], pt[8 * s + 3]); pw.z = pk2(pt[8 * s + 4], pt[8 * s + 5]); pw.w = pk2(pt[8 * s + 6], pt[8 * s + 7]);
        const bf16x8 pb = __builtin_bit_cast(bf16x8, pw);
        const bf16_t* v0 = vb + 16 * s * KSTR;
        const bf16x8 a0 = cat4(vtr(v0), vtr(v0 + 8 * KSTR));
        const bf16x8 a1 = cat4(vtr(v0 + 32), vtr(v0 + 8 * KSTR + 32));
        o0 = mfma32(a0, pb, o0); o1 = mfma32(a1, pb, o1);
    }
}
template <int MASK>
__device__ __forceinline__ void attn_tile_update(const bf16_t* Ks, const bf16_t* Vs, const bf16x8 (&qf)[5], const bf16x8& kf0, const bf16x8& kf1, int lane,
                                                 float rowoff, int qrel, f32x16& o0, f32x16& o1, float& m, float& l) {
    const int l31 = lane & 31, hi = lane >> 5;
    f32x16 s0, s1;
#pragma unroll
    for (int r = 0; r < 16; ++r) { s0[r] = 0.f; s1[r] = 0.f; }
#pragma unroll
    for (int ks = 0; ks < 4; ++ks) {
        const bf16x8 a0 = *(const bf16x8*)(Ks + l31 * KSTR + ks * 16 + hi * 8);
        const bf16x8 a1 = *(const bf16x8*)(Ks + (32 + l31) * KSTR + ks * 16 + hi * 8);
        s0 = mfma32(a0, qf[ks], s0); s1 = mfma32(a1, qf[ks], s1);
    }
    s0 = mfma32(kf0, qf[4], s0); s1 = mfma32(kf1, qf[4], s1);
    if (MASK != 0) {
        const int lim_hi = qrel - 4 * hi, lim_lo = qrel - 512 - 4 * hi;
#pragma unroll
        for (int r = 0; r < 16; ++r) { const int c = (r & 3) + 8 * (r >> 2);
            bool ok0 = true, ok1 = true;
            if (MASK & 1) { ok0 = ok0 && (c <= lim_hi); ok1 = ok1 && (c + 32 <= lim_hi); }
            if (MASK & 2) { ok0 = ok0 && (c > lim_lo); ok1 = ok1 && (c + 32 > lim_lo); }
            s0[r] = ok0 ? s0[r] : -1e30f; s1[r] = ok1 ? s1[r] : -1e30f; } }
    float mt = fmaxf(s0[0], s1[0]);
#pragma unroll
    for (int r = 1; r < 16; ++r) mt = fmaxf(mt, fmaxf(s0[r], s1[r]));
    mt = fmaxf(mt, __shfl_xor(mt, 32)) + rowoff;
    if (__any(mt > m)) { const float mnew = fmaxf(m, mt); const float alpha = fexp2(m - mnew); m = mnew; l *= alpha;
#pragma unroll
        for (int r = 0; r < 16; ++r) { o0[r] *= alpha; o1[r] *= alpha; } }
    const float cc = m - rowoff;
    float ps = 0.f;
#pragma unroll
    for (int r = 0; r < 16; ++r) { s0[r] = fexp2(s0[r] - cc); s1[r] = fexp2(s1[r] - cc); ps += s0[r] + s1[r]; }
    l += ps;
    pv_acc(Vs, 0, s0, lane, o0, o1);
    pv_acc(Vs, 32, s1, lane, o0, o1);
}
__device__ __forceinline__ void make_qfrags(const bf16_t* qp, int lane, float slope2, bf16x8 (&qf)[5], bf16x8& kf0, bf16x8& kf1) {
    const int l31 = lane & 31, hi = lane >> 5;
#pragma unroll
    for (int ks = 0; ks < 4; ++ks) { const bf16x8 raw = *(const bf16x8*)(qp + 16 * ks + 8 * hi); u32x4 w;
        w.x = pk2(bf2f((unsigned short)raw[0]) * ATT_C1, bf2f((unsigned short)raw[1]) * ATT_C1); w.y = pk2(bf2f((unsigned short)raw[2]) * ATT_C1, bf2f((unsigned short)raw[3]) * ATT_C1);
        w.z = pk2(bf2f((unsigned short)raw[4]) * ATT_C1, bf2f((unsigned short)raw[5]) * ATT_C1); w.w = pk2(bf2f((unsigned short)raw[6]) * ATT_C1, bf2f((unsigned short)raw[7]) * ATT_C1);
        qf[ks] = __builtin_bit_cast(bf16x8, w); }
    const unsigned short sh = f2bf(slope2); const unsigned short sl = f2bf(slope2 - bf2f(sh));
    u32x4 a = {0u, 0u, 0u, 0u}, k0 = a, k1 = a;
    if (hi == 0) { a.x = (unsigned)sh | ((unsigned)sl << 16); const unsigned short c0 = f2bf((float)l31), c1 = f2bf((float)(32 + l31)); k0.x = (unsigned)c0 | ((unsigned)c0 << 16); k1.x = (unsigned)c1 | ((unsigned)c1 << 16); }
    qf[4] = __builtin_bit_cast(bf16x8, a); kf0 = __builtin_bit_cast(bf16x8, k0); kf1 = __builtin_bit_cast(bf16x8, k1);
}
__device__ __forceinline__ void kv_load(const bf16_t* kg, const bf16_t* vg, size_t pitch, int tid, bf16x8& kreg, bf16x8& vreg) {
    const int skv = tid >> 3, sp = tid & 7;
    kreg = *(const bf16x8*)(kg + (size_t)skv * pitch + sp * 8); vreg = *(const bf16x8*)(vg + (size_t)skv * pitch + sp * 8);
}
__device__ __forceinline__ void kv_store(bf16_t* Ks, bf16_t* Vs, int tid, const bf16x8& kreg, const bf16x8& vreg) {
    const int skv = tid >> 3, sp = tid & 7;
    *(bf16x8*)(Ks + skv * KSTR + sp * 8) = kreg; *(bf16x8*)(Vs + skv * KSTR + sp * 8) = vreg;
}

__device__ __forceinline__ void nsa_window_unit(const KP& p, unsigned char* lds, int b, int g, int qblk, int tid, int lane, int wave) {
    const bf16_t* P = (const bf16_t*)(p.ws + WS_P);
    bf16_t* TB = (bf16_t*)lds;
    const int l31 = lane & 31, hi = lane >> 5, r = wave >> 1, qh = wave & 1, h = 4 * g + r;
    const int tq = 64 * qblk + 32 * qh + l31; const size_t row = (size_t)b * SEQ + tq;
    const float slope2 = exp2f(-0.5f * (float)(h + 1)) * LOG2E;
    bf16x8 qf[5], kf0, kf1;
    make_qfrags(P + row * PW + PC_Q + h * 64, lane, slope2, qf, kf0, kf1);
    f32x16 o0, o1;
#pragma unroll
    for (int i = 0; i < 16; ++i) { o0[i] = 0.f; o1[i] = 0.f; }
    float m = -1e30f, l = 0.f;
    const int j0 = qblk > 8 ? qblk - 8 : 0, T = qblk - j0 + 1;
    const bf16_t* kg0 = P + ((size_t)b * SEQ) * PW + PC_KW + g * 64;
    bf16x8 kreg, vreg;
    kv_load(kg0 + (size_t)(64 * qblk) * PW, kg0 + (size_t)(64 * qblk) * PW + (PC_VW - PC_KW), PW, tid, kreg, vreg);
    kv_store(TB, TB + TILE_EL, tid, kreg, vreg);
    __syncthreads();
    for (int n = 0; n < T; ++n) { const int j = qblk - n; bf16_t* cur = TB + (n & 1) * 2 * TILE_EL; bf16_t* nxt = TB + ((n + 1) & 1) * 2 * TILE_EL;
        if (n + 1 < T) kv_load(kg0 + (size_t)(64 * (j - 1)) * PW, kg0 + (size_t)(64 * (j - 1)) * PW + (PC_VW - PC_KW), PW, tid, kreg, vreg);
        const int qrel = tq - 64 * j; const float rowoff = -slope2 * (float)qrel;
        if (n == 0) attn_tile_update<1>(cur, cur + TILE_EL, qf, kf0, kf1, lane, rowoff, qrel, o0, o1, m, l);
        else if (j == qblk - 8) attn_tile_update<2>(cur, cur + TILE_EL, qf, kf0, kf1, lane, rowoff, qrel, o0, o1, m, l);
        else attn_tile_update<0>(cur, cur + TILE_EL, qf, kf0, kf1, lane, rowoff, qrel, o0, o1, m, l);
        if (n + 1 < T) kv_store(nxt, nxt + TILE_EL, tid, kreg, vreg);
        __syncthreads(); }
    l += __shfl_xor(l, 32);
    const float gate = sigmoid_f(bf2f(P[row * PW + PC_GATE + h * 3 + 2]));
    const float sc = gate / l;
    bf16_t* ow = (bf16_t*)(p.ws + WS_OW) + row * 1024 + h * 64;
#pragma unroll
    for (int c4 = 0; c4 < 4; ++c4) { const int d = 8 * c4 + 4 * hi;
        u32x2 w0; w0.x = pk2(o0[4 * c4] * sc, o0[4 * c4 + 1] * sc); w0.y = pk2(o0[4 * c4 + 2] * sc, o0[4 * c4 + 3] * sc); *(u32x2*)(ow + d) = w0;
        u32x2 w1; w1.x = pk2(o1[4 * c4] * sc, o1[4 * c4 + 1] * sc); w1.y = pk2(o1[4 * c4 + 2] * sc, o1[4 * c4 + 3] * sc); *(u32x2*)(ow + 32 + d) = w1; }
}

__device__ __forceinline__ void nsa_cmp_sel_unit(const KP& p, unsigned char* lds, int b, int g, int qblk, int tid, int lane, int wave) {
    const bf16_t* P = (const bf16_t*)(p.ws + WS_P);
    bf16_t* TB = (bf16_t*)lds;
    bf16_t* KsC = (bf16_t*)(lds + 36864); bf16_t* VsC = (bf16_t*)(lds + 55296);
    float* IMP = (float*)(lds + 36864); unsigned* SELM = (unsigned*)(lds + 36864 + 8192);
    float* Gs = (float*)(lds + 73728); float* Ls = Gs + 4 * 64 * 32;
    const int l31 = lane & 31, hi = lane >> 5, r = wave >> 1, qh = wave & 1, h = 4 * g + r, ql = 32 * qh + l31;
    const int tq = 64 * qblk + ql; const size_t row = (size_t)b * SEQ + tq;
    const float slope2 = exp2f(-0.5f * (float)(h + 1)) * LOG2E;
    bf16x8 qf[5], kf0, kf1;
    make_qfrags(P + row * PW + PC_Q + h * 64, lane, slope2, qf, kf0, kf1);
    const float g_c = sigmoid_f(bf2f(P[row * PW + PC_GATE + h * 3 + 0])), g_s = sigmoid_f(bf2f(P[row * PW + PC_GATE + h * 3 + 1]));
    const bf16_t* kg0 = P + ((size_t)b * SEQ) * PW + PC_KS + g * 64;
    bf16x8 kreg, vreg;
    f32x16 acc0, acc1;
    {
        const bf16_t* kc = (const bf16_t*)(p.ws + WS_KC) + (size_t)(b * 4 + g) * 128 * 64;
        const bf16_t* vc = (const bf16_t*)(p.ws + WS_VCT) + (size_t)(b * 4 + g) * 128 * 64;
        for (int i = tid; i < 1024; i += NTHREADS) { const int n = i >> 3, sp = i & 7; *(bf16x8*)(KsC + n * KSTR + sp * 8) = *(const bf16x8*)(kc + n * 64 + sp * 8); *(bf16x8*)(VsC + n * KSTR + sp * 8) = *(const bf16x8*)(vc + n * 64 + sp * 8); }
        __syncthreads();
        f32x16 s[4];
#pragma unroll
        for (int t = 0; t < 4; ++t) {
#pragma unroll
            for (int i = 0; i < 16; ++i) s[t][i] = 0.f;
#pragma unroll
            for (int ks = 0; ks < 4; ++ks) { const bf16x8 a = *(const bf16x8*)(KsC + (32 * t + l31) * KSTR + ks * 16 + hi * 8); s[t] = mfma32(a, qf[ks], s[t]); } }
        const float dbase = (float)tq - 15.5f - 64.0f * (float)hi;
        float mt = -1e30f;
#pragma unroll
        for (int t = 0; t < 4; ++t)
#pragma unroll
            for (int i = 0; i < 16; ++i) { const float c = (float)(32 * t + (i & 3) + 8 * (i >> 2)); const float d = dbase - 16.0f * c;
                const float v = s[t][i] - slope2 * d; s[t][i] = (d >= 15.5f) ? v : -1e30f; mt = fmaxf(mt, s[t][i]); }
        mt = fmaxf(mt, __shfl_xor(mt, 32));
        float ps = 0.f;
#pragma unroll
        for (int t = 0; t < 4; ++t)
#pragma unroll
            for (int i = 0; i < 16; ++i) { const float pv = s[t][i] > -1e29f ? fexp2(s[t][i] - mt) : 0.f; s[t][i] = pv; ps += pv; }
        ps += __shfl_xor(ps, 32);
        const float linv = ps > 0.f ? 1.0f / ps : 0.f;
#pragma unroll
        for (int t = 0; t < 4; ++t)
#pragma unroll
            for (int i = 0; i < 16; ++i) s[t][i] *= linv;
#pragma unroll
        for (int t = 0; t < 4; ++t)
#pragma unroll
            for (int c4 = 0; c4 < 4; ++c4) { const int jj = 8 * t + 2 * c4 + hi; const int o = (r * 64 + ql) * 32 + jj;
                Gs[o] = (s[t][4 * c4] + s[t][4 * c4 + 1]) + (s[t][4 * c4 + 2] + s[t][4 * c4 + 3]); Ls[o] = s[t][4 * c4 + 3]; }
        f32x16 o0, o1;
#pragma unroll
        for (int i = 0; i < 16; ++i) { o0[i] = 0.f; o1[i] = 0.f; }
#pragma unroll
        for (int t = 0; t < 4; ++t) pv_acc(VsC, 32 * t, s[t], lane, o0, o1);
#pragma unroll
        for (int i = 0; i < 16; ++i) { acc0[i] = g_c * o0[i]; acc1[i] = g_c * o1[i]; }
    }
    kv_load(kg0 + (size_t)(64 * qblk) * PW, kg0 + (size_t)(64 * qblk) * PW + (PC_VS - PC_KS), PW, tid, kreg, vreg);
    __syncthreads();
    for (int idx = tid; idx < 64 * 32; idx += NTHREADS) { const int q = idx >> 5, j = idx & 31; float v = 0.f;
#pragma unroll
        for (int hh = 0; hh < 4; ++hh) { v += Gs[(hh * 64 + q) * 32 + j]; if (j > 0) v += Ls[(hh * 64 + q) * 32 + j - 1]; }
        IMP[idx] = v; }
    __syncthreads();
#pragma unroll 1
    for (int it = 0; it < 4; ++it) { const int q = 2 * (8 * it + wave) + (lane >> 5), j = lane & 31; bool sel;
        if (qblk < 16) sel = (j <= qblk);
        else { const bool forced = (j == 0) || (j == qblk) || (j == qblk - 1); const bool cand = (j >= 1) && (j <= qblk - 2);
            const float v = IMP[q * 32 + j]; int rank = 0;
            for (int j2 = 1; j2 <= qblk - 2; ++j2) { const float v2 = IMP[q * 32 + j2]; rank += (v2 > v || (v2 == v && j2 < j)) ? 1 : 0; }
            sel = forced || (cand && rank < 13); }
        const unsigned long long bm = __ballot(sel);
        if (j == 0) SELM[q] = (lane >> 5) ? (unsigned)(bm >> 32) : (unsigned)bm; }
    kv_store(TB, TB + TILE_EL, tid, kreg, vreg);
    __syncthreads();
    unsigned um = 0u;
    for (int i = 0; i < 64; ++i) um |= SELM[i];
    um = __builtin_amdgcn_readfirstlane(um) & (qblk >= 31 ? 0xffffffffu : ((2u << qblk) - 1u));
    const unsigned mymask = SELM[ql];
    {
        f32x16 o0, o1;
#pragma unroll
        for (int i = 0; i < 16; ++i) { o0[i] = 0.f; o1[i] = 0.f; }
        float m = -1e30f, l = 0.f;
        unsigned rem = um & ~(1u << qblk); int j = qblk, n = 0;
        for (;;) { bf16_t* cur = TB + (n & 1) * 2 * TILE_EL; bf16_t* nxt = TB + ((n + 1) & 1) * 2 * TILE_EL;
            const int jn = rem ? 31 - __builtin_clz(rem) : -1;
            if (jn >= 0) kv_load(kg0 + (size_t)(64 * jn) * PW, kg0 + (size_t)(64 * jn) * PW + (PC_VS - PC_KS), PW, tid, kreg, vreg);
            const int qrel = tq - 64 * j; const float rowoff = -slope2 * (float)qrel + (((mymask >> j) & 1u) ? 0.f : -1e30f);
            if (n == 0) attn_tile_update<1>(cur, cur + TILE_EL, qf, kf0, kf1, lane, rowoff, qrel, o0, o1, m, l);
            else attn_tile_update<0>(cur, cur + TILE_EL, qf, kf0, kf1, lane, rowoff, qrel, o0, o1, m, l);
            if (jn < 0) break;
            kv_store(nxt, nxt + TILE_EL, tid, kreg, vreg);
            __syncthreads();
            rem &= ~(1u << jn); j = jn; ++n; }
        l += __shfl_xor(l, 32);
        const float sc = g_s / l;
#pragma unroll
        for (int i = 0; i < 16; ++i) { acc0[i] += sc * o0[i]; acc1[i] += sc * o1[i]; }
    }
    const bf16_t* ow = (const bf16_t*)(p.ws + WS_OW) + row * 1024 + h * 64;
    bf16_t* mx = (bf16_t*)(p.ws + WS_H) + row * DM + h * 64;
#pragma unroll
    for (int c4 = 0; c4 < 4; ++c4) { const int d = 8 * c4 + 4 * hi;
        const u32x2 a = *(const u32x2*)(ow + d), bq = *(const u32x2*)(ow + 32 + d);
        const float w0 = acc0[4 * c4] + __uint_as_float(a.x << 16), w1 = acc0[4 * c4 + 1] + __uint_as_float(a.x & 0xffff0000u), w2 = acc0[4 * c4 + 2] + __uint_as_float(a.y << 16), w3 = acc0[4 * c4 + 3] + __uint_as_float(a.y & 0xffff0000u);
        const float x0 = acc1[4 * c4] + __uint_as_float(bq.x << 16), x1 = acc1[4 * c4 + 1] + __uint_as_float(bq.x & 0xffff0000u), x2 = acc1[4 * c4 + 2] + __uint_as_float(bq.y << 16), x3 = acc1[4 * c4 + 3] + __uint_as_float(bq.y & 0xffff0000u);
        u32x2 o; o.x = pk2(w0, w1); o.y = pk2(w2, w3); *(u32x2*)(mx + d) = o;
        u32x2 o2; o2.x = pk2(x0, x1); o2.y = pk2(x2, x3); *(u32x2*)(mx + 32 + d) = o2; }
}

__device__ __forceinline__ float gelu_tanh(float x) { const float u = 0.7978845608028654f * (x + 0.044715f * x * x * x); const float e = fexp(2.0f * u); return 0.5f * x * (2.0f - 2.0f / (e + 1.0f)); }
__device__ __forceinline__ void nsa_compress_unit(const KP& p, unsigned char* lds, int cu, int tid, int lane, int wave) {
    const int kv = cu >> 7, b = (cu >> 5) & 3, g = (cu >> 3) & 3, nt = cu & 7;
    const bf16_t* P = (const bf16_t*)(p.ws + WS_P);
    const bf16_t* W1T = (const bf16_t*)(p.ws + (kv ? WS_W1TV : WS_W1TK)); const bf16_t* W2T = (const bf16_t*)(p.ws + (kv ? WS_W2TV : WS_W2TK));
    float* PART = (float*)lds;
    bf16_t* HS = (bf16_t*)(lds + 32768);
    const int fr = lane & 15, fq = lane >> 4;
    int n = 16 * nt + fr; if (n > 126) n = 126;
    const int colbase = (kv ? PC_VC : PC_KC) + g * 64;
    f32x4 acc[4];
#pragma unroll
    for (int i = 0; i < 4; ++i) acc[i] = (f32x4){0.f, 0.f, 0.f, 0.f};
#pragma unroll
    for (int ks = 0; ks < 8; ++ks) { const int kg = 256 * wave + 32 * ks + 8 * fq; const int t = kg >> 6, d = kg & 63;
        const bf16x8 a = *(const bf16x8*)(P + ((size_t)b * SEQ + 16 * n + t) * PW + colbase + d);
#pragma unroll
        for (int ntile = 0; ntile < 4; ++ntile) { const bf16x8 bb = *(const bf16x8*)(W1T + (size_t)(ntile * 16 + fr) * 2048 + kg); acc[ntile] = mfma16(a, bb, acc[ntile]); } }
    __syncthreads();
#pragma unroll
    for (int ntile = 0; ntile < 4; ++ntile)
#pragma unroll
        for (int i = 0; i < 4; ++i) PART[(wave * 16 + fq * 4 + i) * 64 + ntile * 16 + fr] = acc[ntile][i];
    __syncthreads();
    { const int rr = tid >> 5, c2 = (tid & 31) * 2; float v0 = ((const float*)(p.ws + WS_POSW1))[kv * 64 + c2], v1 = ((const float*)(p.ws + WS_POSW1))[kv * 64 + c2 + 1];
#pragma unroll
      for (int w = 0; w < 8; ++w) { v0 += PART[(w * 16 + rr) * 64 + c2]; v1 += PART[(w * 16 + rr) * 64 + c2 + 1]; }
      *(unsigned*)(HS + rr * KSTR + c2) = pk2(gelu_tanh(v0), gelu_tanh(v1)); }
    __syncthreads();
    if (wave < 4) { f32x4 a2 = (f32x4){0.f, 0.f, 0.f, 0.f};
#pragma unroll
        for (int s = 0; s < 2; ++s) { const bf16x8 a = *(const bf16x8*)(HS + fr * KSTR + 32 * s + 8 * fq); const bf16x8 bb = *(const bf16x8*)(W2T + (wave * 16 + fr) * 64 + 32 * s + 8 * fq); a2 = mfma16(a, bb, a2); }
        const int d = wave * 16 + fr;
#pragma unroll
        for (int i = 0; i < 4; ++i) { const int nn = 16 * nt + fq * 4 + i; const float val = nn <= 126 ? a2[i] : 0.f;
            if (kv == 0) ((bf16_t*)(p.ws + WS_KC))[((size_t)(b * 4 + g) * 128 + nn) * 64 + d] = f2bf(val);
            else ((bf16_t*)(p.ws + WS_VCT))[((size_t)(b * 4 + g) * 128 + nn) * 64 + d] = f2bf(val); } }
}

#ifndef GLA_REP1
#define GLA_REP1 1
#define GLA_REP2 1
#define GLA_REP0 1
#endif
__device__ __forceinline__ void gla_a_unit(const KP& p, unsigned char* lds, int u, int tid, int lane, int wave) {
    const bf16_t* P = (const bf16_t*)(p.ws + WS_P);
    const int c = u & 31, h = (u >> 5) & 3, b = u >> 7;
    float* BL = (float*)lds;
    bf16_t* QT = (bf16_t*)(lds + 32768);
    bf16_t* KH = (bf16_t*)(lds + 50176);
    bf16_t* KN = (bf16_t*)(lds + 67584);
    bf16_t* VN = (bf16_t*)(lds + 84992);
    bf16_t* AT = (bf16_t*)(lds + 118784);
    float* SEG = (float*)(lds + 128000);
    float* LR = (float*)(lds + 118784);
    float* WG = (float*)(lds + 130048);
    constexpr int VP = 264;
    const int l31 = lane & 31, hi = lane >> 5, l15 = lane & 15, g1 = (lane >> 4) & 1;
    const int gk = tid & 127, seg = tid >> 7;
    const size_t row0 = (size_t)b * SEQ + 64 * c;
    const float qscale = 0.08838834764831845f;
    const float bg = p.in(13)[h * 128 + gk];
    const unsigned short lr0 = P[(row0 + (tid >> 4)) * PW + PC_LR + (tid & 15)], lr1 = P[(row0 + 32 + (tid >> 4)) * PW + PC_LR + (tid & 15)];
    bf16x8 qv[2], kv[2], vv[4];
#pragma unroll
    for (int ps = 0; ps < 2; ++ps) { const int i = 32 * ps + (tid >> 4), k8 = (tid & 15) * 8;
        qv[ps] = *(const bf16x8*)(P + (row0 + i) * PW + PC_GQ + h * 128 + k8); kv[ps] = *(const bf16x8*)(P + (row0 + i) * PW + PC_GK + h * 128 + k8); }
#pragma unroll
    for (int ps = 0; ps < 4; ++ps) { const int i = 16 * ps + (tid >> 5), d8 = (tid & 31) * 8; vv[ps] = *(const bf16x8*)(P + (row0 + i) * PW + PC_GV + h * 256 + d8); }
    for (int rp_ = 0; rp_ < GLA_REP0; ++rp_) {
    __syncthreads();
    for (int i = tid; i < 2048; i += NTHREADS) WG[i] = p.in(12)[(i >> 7) * 512 + h * 128 + (i & 127)];
    LR[tid] = bf2f(lr0); LR[512 + tid] = bf2f(lr1);
#pragma unroll
    for (int ps = 0; ps < 4; ++ps) { const int i = 16 * ps + (tid >> 5), d8 = (tid & 31) * 8; *(bf16x8*)(VN + i * VP + d8) = vv[ps]; }
    __syncthreads(); }
    for (int rp_ = 0; rp_ < GLA_REP1; ++rp_)
    { float run = 0.f;
      for (int ii = 0; ii < 16; ++ii) { const int i = 16 * seg + ii; float z = bg;
#pragma unroll
          for (int r = 0; r < 16; ++r) z += LR[i * 16 + r] * WG[r * 128 + gk];
          const float la = (fminf(z, 0.f) - __logf(1.0f + __expf(-fabsf(z)))) * 0.0625f;
          run += la; BL[i * 128 + gk] = run; }
      SEG[seg * 128 + gk] = run; }
    __syncthreads();
    if (tid < 128) ((float*)(p.ws + WS_GDEC))[(size_t)u * 128 + tid] = __expf(SEG[tid] + SEG[128 + tid] + SEG[256 + tid] + SEG[384 + tid]);
    for (int rp_ = 0; rp_ < GLA_REP2; ++rp_)
#pragma unroll
    for (int ps = 0; ps < 2; ++ps) { const int i = 32 * ps + (tid >> 4), k8 = (tid & 15) * 8; const int sg = i >> 4;
        float qe[8], ke[8], kn[8];
#pragma unroll
        for (int j = 0; j < 8; ++j) { const int k = k8 + j; float pre = 0.f, tot = 0.f;
#pragma unroll
            for (int s2 = 0; s2 < 4; ++s2) { const float sv = SEG[s2 * 128 + k]; tot += sv; if (s2 < sg) pre += sv; }
            const float bb = BL[i * 128 + k] + pre; const float kf = bf2f((unsigned short)kv[ps][j]);
            qe[j] = bf2f((unsigned short)qv[ps][j]) * qscale * __expf(bb); ke[j] = kf * __expf(-bb); kn[j] = kf * __expf(tot - bb); }
        u32x4 w; w.x = pk2(qe[0], qe[1]); w.y = pk2(qe[2], qe[3]); w.z = pk2(qe[4], qe[5]); w.w = pk2(qe[6], qe[7]); *(u32x4*)(QT + i * 136 + k8) = w;
        *(u32x4*)((bf16_t*)(p.ws + WS_GQT) + ((size_t)u * 64 + i) * 128 + k8) = w;
        u32x4 w2; w2.x = pk2(ke[0], ke[1]); w2.y = pk2(ke[2], ke[3]); w2.z = pk2(ke[4], ke[5]); w2.w = pk2(ke[6], ke[7]); *(u32x4*)(KH + i * 136 + k8) = w2;
        u32x4 w3; w3.x = pk2(kn[0], kn[1]); w3.y = pk2(kn[2], kn[3]); w3.z = pk2(kn[4], kn[5]); w3.w = pk2(kn[6], kn[7]); *(u32x4*)(KN + i * 136 + k8) = w3; }
    __syncthreads();
    if (wave < 4) { const int jt = wave >> 1, itl = wave & 1;
        f32x16 cacc;
#pragma unroll
        for (int i = 0; i < 16; ++i) cacc[i] = 0.f;
        if (!(jt == 1 && itl == 0)) {
#pragma unroll
            for (int ks = 0; ks < 8; ++ks) { const bf16x8 a = *(const bf16x8*)(KH + (32 * jt + l31) * 136 + 16 * ks + 8 * hi); const bf16x8 bb = *(const bf16x8*)(QT + (32 * itl + l31) * 136 + 16 * ks + 8 * hi); cacc = mfma32(a, bb, cacc); } }
        const int i = 32 * itl + l31;
#pragma unroll
        for (int c4 = 0; c4 < 4; ++c4) { const int jb = 32 * jt + 8 * c4 + 4 * hi;
            const float a0 = (jb + 0 <= i) ? cacc[4 * c4 + 0] : 0.f, a1 = (jb + 1 <= i) ? cacc[4 * c4 + 1] : 0.f, a2 = (jb + 2 <= i) ? cacc[4 * c4 + 2] : 0.f, a3 = (jb + 3 <= i) ? cacc[4 * c4 + 3] : 0.f;
            u32x2 w; w.x = pk2(a0, a1); w.y = pk2(a2, a3); *(u32x2*)(AT + i * KSTR + jb) = w; } }
    __syncthreads();
    bf16x8 vf[4];
    { const bf16_t* vb = VN + (8 * hi + (l15 >> 2)) * VP + 32 * wave + 16 * g1 + 4 * (l15 & 3);
#pragma unroll
      for (int s4 = 0; s4 < 4; ++s4) vf[s4] = cat4(vtr(vb + (16 * s4) * VP), vtr(vb + (16 * s4 + 4) * VP)); }
    { f32x16 oT[2];
#pragma unroll
      for (int i = 0; i < 16; ++i) { oT[0][i] = 0.f; oT[1][i] = 0.f; }
#pragma unroll
      for (int s4 = 0; s4 < 4; ++s4) {
          oT[0] = mfma32(vf[s4], *(const bf16x8*)(AT + l31 * KSTR + 16 * s4 + 8 * hi), oT[0]);
          oT[1] = mfma32(vf[s4], *(const bf16x8*)(AT + (32 + l31) * KSTR + 16 * s4 + 8 * hi), oT[1]); }
      bf16_t* oi = (bf16_t*)(p.ws + WS_GOI) + (size_t)u * 64 * 256 + 32 * wave;
#pragma unroll
      for (int itl = 0; itl < 2; ++itl)
#pragma unroll
          for (int c4 = 0; c4 < 4; ++c4) { u32x2 w; w.x = pk2(oT[itl][4 * c4], oT[itl][4 * c4 + 1]); w.y = pk2(oT[itl][4 * c4 + 2], oT[itl][4 * c4 + 3]);
              *(u32x2*)(oi + (size_t)(32 * itl + l31) * 256 + 8 * c4 + 4 * hi) = w; } }
    { f32x16 D[4];
      const bf16_t* kb = KN + (8 * hi + (l15 >> 2)) * 136 + 16 * g1 + 4 * (l15 & 3);
#pragma unroll
      for (int dkt = 0; dkt < 4; ++dkt) {
#pragma unroll
          for (int i = 0; i < 16; ++i) D[dkt][i] = 0.f;
#pragma unroll
          for (int s4 = 0; s4 < 4; ++s4) { const bf16x8 a = cat4(vtr(kb + (16 * s4) * 136 + 32 * dkt), vtr(kb + (16 * s4 + 4) * 136 + 32 * dkt)); D[dkt] = mfma32(a, vf[s4], D[dkt]); } }
      __syncthreads();
      bf16_t* st = (bf16_t*)lds + wave * (32 * 136);
#pragma unroll
      for (int dkt = 0; dkt < 4; ++dkt)
#pragma unroll
          for (int c4 = 0; c4 < 4; ++c4) { u32x2 w; w.x = pk2(D[dkt][4 * c4], D[dkt][4 * c4 + 1]); w.y = pk2(D[dkt][4 * c4 + 2], D[dkt][4 * c4 + 3]);
              *(u32x2*)(st + l31 * 136 + 32 * dkt + 8 * c4 + 4 * hi) = w; }
      asm volatile("s_waitcnt lgkmcnt(0)" ::: "memory");
      bf16_t* ds = (bf16_t*)(p.ws + WS_GDS) + ((size_t)u * 256 + 32 * wave) * 128;
#pragma unroll
      for (int it = 0; it < 8; ++it) { const int rr = it * 4 + (lane >> 4), ch = lane & 15; *(u32x4*)(ds + (size_t)rr * 128 + ch * 8) = *(const u32x4*)(st + rr * 136 + ch * 8); } }
}
__device__ __forceinline__ void gla_scan(const KP& p, int tid) {
    const bf16_t* DS = (const bf16_t*)(p.ws + WS_GDS); bf16_t* SS = (bf16_t*)(p.ws + WS_GSS); const float* DEC = (const float*)(p.ws + WS_GDEC);
    for (int gt = blockIdx.x * NTHREADS + tid; gt < 16 * 8192; gt += gridDim.x * NTHREADS) { const int bh = gt >> 13, rem = gt & 8191, dv = rem >> 5, dk4 = (rem & 31) * 4;
        float s0 = 0.f, s1 = 0.f, s2 = 0.f, s3 = 0.f;
#pragma unroll 8
        for (int c = 0; c < 32; ++c) { const size_t u = (size_t)bh * 32 + c; const size_t o = (u * 256 + dv) * 128 + dk4;
            const u32x2 d = *(const u32x2*)(DS + o); const f32x4 dec = *(const f32x4*)(DEC + u * 128 + dk4);
            u32x2 w; w.x = pk2(s0, s1); w.y = pk2(s2, s3); *(u32x2*)(SS + o) = w;
            s0 = dec.x * s0 + __uint_as_float(d.x << 16); s1 = dec.y * s1 + __uint_as_float(d.x & 0xffff0000u); s2 = dec.z * s2 + __uint_as_float(d.y << 16); s3 = dec.w * s3 + __uint_as_float(d.y & 0xffff0000u); } }
}
__device__ __forceinline__ void gla_c_unit(const KP& p, unsigned char* lds, int u, int tid, int lane, int wave) {
    const bf16_t* P = (const bf16_t*)(p.ws + WS_P);
    const int c = u & 31, h = (u >> 5) & 3, b = u >> 7;
    float* SSQ = (float*)lds;
    const int l31 = lane & 31, hi = lane >> 5;
    const size_t row0 = (size_t)b * SEQ + 64 * c;
    const bf16_t* SS = (const bf16_t*)(p.ws + WS_GSS) + ((size_t)u * 256 + 32 * wave + l31) * 128 + 8 * hi;
    const bf16_t* QG = (const bf16_t*)(p.ws + WS_GQT) + ((size_t)u * 64 + l31) * 128 + 8 * hi;
    const bf16_t* oi = (const bf16_t*)(p.ws + WS_GOI) + (size_t)u * 64 * 256 + 32 * wave;
    bf16x8 sa[8], q0[8], q1[8]; u32x2 oiv[2][4], ogv[2][4]; f32x4 nwv[4];
#pragma unroll
    for (int ks = 0; ks < 8; ++ks) { sa[ks] = *(const bf16x8*)(SS + 16 * ks); q0[ks] = *(const bf16x8*)(QG + 16 * ks); q1[ks] = *(const bf16x8*)(QG + 32 * 128 + 16 * ks); }
#pragma unroll
    for (int itl = 0; itl < 2; ++itl)
#pragma unroll
        for (int c4 = 0; c4 < 4; ++c4) { oiv[itl][c4] = *(const u32x2*)(oi + (size_t)(32 * itl + l31) * 256 + 8 * c4 + 4 * hi);
            ogv[itl][c4] = *(const u32x2*)(P + (row0 + 32 * itl + l31) * PW + PC_GO + h * 256 + 32 * wave + 8 * c4 + 4 * hi); }
#pragma unroll
    for (int c4 = 0; c4 < 4; ++c4) nwv[c4] = *(const f32x4*)(p.in(14) + 32 * wave + 8 * c4 + 4 * hi);
    f32x16 oT[2];
#pragma unroll
    for (int i = 0; i < 16; ++i) { oT[0][i] = 0.f; oT[1][i] = 0.f; }
#pragma unroll
    for (int ks = 0; ks < 8; ++ks) { oT[0] = mfma32(sa[ks], q0[ks], oT[0]); oT[1] = mfma32(sa[ks], q1[ks], oT[1]); }
#pragma unroll
    for (int itl = 0; itl < 2; ++itl)
#pragma unroll
        for (int c4 = 0; c4 < 4; ++c4) { const u32x2 w = oiv[itl][c4];
            oT[itl][4 * c4] += __uint_as_float(w.x << 16); oT[itl][4 * c4 + 1] += __uint_as_float(w.x & 0xffff0000u); oT[itl][4 * c4 + 2] += __uint_as_float(w.y << 16); oT[itl][4 * c4 + 3] += __uint_as_float(w.y & 0xffff0000u); }
    { float q0s = 0.f, q1s = 0.f;
#pragma unroll
      for (int i = 0; i < 16; ++i) { q0s += oT[0][i] * oT[0][i]; q1s += oT[1][i] * oT[1][i]; }
      q0s += __shfl_xor(q0s, 32); q1s += __shfl_xor(q1s, 32);
      if (hi == 0) { SSQ[wave * 64 + l31] = q0s; SSQ[wave * 64 + 32 + l31] = q1s; } }
    __syncthreads();
#pragma unroll
    for (int itl = 0; itl < 2; ++itl) { const int i = 32 * itl + l31; float tot = 0.f;
#pragma unroll
        for (int w = 0; w < 8; ++w) tot += SSQ[w * 64 + i];
        const float rstd = rsqrtf(tot * (1.0f / 256.0f) + EPS);
        bf16_t* mx = (bf16_t*)(p.ws + WS_H) + (row0 + i) * DM + 1024 + h * 256 + 32 * wave;
#pragma unroll
        for (int c4 = 0; c4 < 4; ++c4) { const int d = 8 * c4 + 4 * hi; const u32x2 gq = ogv[itl][c4]; const f32x4 nw = nwv[c4];
            const float g0 = __uint_as_float(gq.x << 16), g1 = __uint_as_float(gq.x & 0xffff0000u), g2 = __uint_as_float(gq.y << 16), g3 = __uint_as_float(gq.y & 0xffff0000u);
            const float v0 = oT[itl][4 * c4] * rstd * nw.x * pg8::silu_f(g0), v1 = oT[itl][4 * c4 + 1] * rstd * nw.y * pg8::silu_f(g1), v2 = oT[itl][4 * c4 + 2] * rstd * nw.z * pg8::silu_f(g2), v3 = oT[itl][4 * c4 + 3] * rstd * nw.w * pg8::silu_f(g3);
            u32x2 o; o.x = pk2(v0, v1); o.y = pk2(v2, v3); *(u32x2*)(mx + d) = o; } }
}

__device__ __forceinline__ void p6_norm2_route(const KP& p, unsigned char* lds, int tid, int lane, int wave) {
    unsigned char* ws = p.ws; const float* X2 = p.out; bf16_t* H2 = (bf16_t*)(ws + WS_H);
    const bf16_t* WRH = (const bf16_t*)(ws + WS_WRH); const bf16_t* WRL = (const bf16_t*)(ws + WS_WRL);
    float* LG = (float*)(lds + wave * 4096);
    const int fr = lane & 15, fq = lane >> 4, kq = wave & 3;
    unsigned* ctl = (unsigned*)(ws + WS_CTL);
    for (int t0 = 2 * blockIdx.x; t0 < 512; t0 += 2 * gridDim.x) {
        const int task = t0 + (wave >> 2); const int row0 = 16 * task, b = row0 >> 11;
        float myrstd;
        { const f32x4* sp = (const f32x4*)((const float*)(ws + WS_SSQP) + (size_t)(row0 + fr) * 32); float tot = 0.f;
#pragma unroll
          for (int j = 0; j < 8; ++j) { const f32x4 v = sp[j]; tot += (v.x + v.y) + (v.z + v.w); }
          myrstd = rsqrtf(tot * (1.0f / DM) + EPS); }
        const float* xrow = X2 + (size_t)(row0 + fr) * DM; const float* a2 = (const float*)(ws + WS_A2G) + b * 2048; const float* s2 = (const float*)(ws + WS_SH2G) + b * 2048;
        bf16_t* hrow = H2 + (size_t)(row0 + fr) * DM;
        f32x4 acc[3];
#pragma unroll
        for (int i = 0; i < 3; ++i) acc[i] = (f32x4){0.f, 0.f, 0.f, 0.f};
#pragma unroll 4
        for (int ks = 0; ks < 16; ++ks) { const int k0 = 512 * kq + 32 * ks + 8 * fq;
            const f32x4 x0 = *(const f32x4*)(xrow + k0), x1 = *(const f32x4*)(xrow + k0 + 4), aa0 = *(const f32x4*)(a2 + k0), aa1 = *(const f32x4*)(a2 + k0 + 4), ss0 = *(const f32x4*)(s2 + k0), ss1 = *(const f32x4*)(s2 + k0 + 4);
            const f32x4 h0 = x0 * myrstd * aa0 + ss0, h1 = x1 * myrstd * aa1 + ss1;
            u32x4 hw; hw.x = pk2(h0.x, h0.y); hw.y = pk2(h0.z, h0.w); hw.z = pk2(h1.x, h1.y); hw.w = pk2(h1.z, h1.w);
            *(u32x4*)(hrow + k0) = hw;
            u32x4 lw; lw.x = pk2(h0.x - __uint_as_float(hw.x << 16), h0.y - __uint_as_float(hw.x & 0xffff0000u)); lw.y = pk2(h0.z - __uint_as_float(hw.y << 16), h0.w - __uint_as_float(hw.y & 0xffff0000u));
            lw.z = pk2(h1.x - __uint_as_float(hw.z << 16), h1.y - __uint_as_float(hw.z & 0xffff0000u)); lw.w = pk2(h1.z - __uint_as_float(hw.w << 16), h1.w - __uint_as_float(hw.w & 0xffff0000u));
            const bf16x8 hf = __builtin_bit_cast(bf16x8, hw), lf = __builtin_bit_cast(bf16x8, lw);
#pragma unroll
            for (int nt = 0; nt < 3; ++nt) { const bf16x8 bh = *(const bf16x8*)(WRH + (size_t)(nt * 16 + fr) * 2048 + k0), bl = *(const bf16x8*)(WRL + (size_t)(nt * 16 + fr) * 2048 + k0);
                acc[nt] = mfma16(hf, bh, acc[nt]); acc[nt] = mfma16(hf, bl, acc[nt]); acc[nt] = mfma16(lf, bh, acc[nt]); } }
#pragma unroll
        for (int nt = 0; nt < 3; ++nt)
#pragma unroll
            for (int i = 0; i < 4; ++i) LG[(fq * 4 + i) * 49 + nt * 16 + fr] = acc[nt][i];
        __syncthreads();
        if (kq == 0 && lane < 16) { const float* lg = LG + lane * 49; const int tok = row0 + lane;
            float gl[4]; int grp = 0; float gmax = -1e30f;
#pragma unroll
            for (int j = 0; j < 4; ++j) { gl[j] = ((lg[32 + j] + lg[1024 + 32 + j]) + (lg[2048 + 32 + j] + lg[3072 + 32 + j])) + p.in(18)[j]; if (gl[j] > gmax) { gmax = gl[j]; grp = j; } }
            float gs = 0.f;
#pragma unroll
            for (int j = 0; j < 4; ++j) gs += __expf(gl[j] - gmax);
            const float grp_p = 1.0f / gs;
            float v1 = -1e30f, v2 = -1e30f; int i1 = 0, i2 = 0;
            for (int j = 0; j < 8; ++j) { const int e = grp * 8 + j; const float v = ((lg[e] + lg[1024 + e]) + (lg[2048 + e] + lg[3072 + e])) + p.in(20)[e];
                if (v > v1) { v2 = v1; i2 = i1; v1 = v; i1 = j; } else if (v > v2) { v2 = v; i2 = j; } }
            const float e2 = __expf(v2 - v1); const float w1 = grp_p / (1.0f + e2), w2 = grp_p * e2 / (1.0f + e2);
            const int ea = grp * 8 + i1, eb = grp * 8 + i2;
            const int pa = (int)atomicAdd(ctl + CW_ECNT + 16 * ea, 1u), pb = (int)atomicAdd(ctl + CW_ECNT + 16 * eb, 1u);
            int* te = (int*)(ws + WS_TOKE); float* tw = (float*)(ws + WS_TOKW); int* tp = (int*)(ws + WS_TOKP);
            te[2 * tok] = ea; te[2 * tok + 1] = eb; tw[2 * tok] = w1; tw[2 * tok + 1] = w2; tp[2 * tok] = pa; tp[2 * tok + 1] = pb; }
        __syncthreads();
    }
}

__device__ __forceinline__ void p7_dispatch(const KP& p, unsigned char* lds, int tid, int lane, int wave) {
    unsigned char* ws = p.ws; unsigned* ctl = (unsigned*)(ws + WS_CTL);
    int* PST = (int*)lds;
    volatile int* PSTv = (volatile int*)PST;
    if (tid < 32) PSTv[64 + tid] = (int)__hip_atomic_load(ctl + CW_ECNT + 16 * tid, __ATOMIC_RELAXED, __HIP_MEMORY_SCOPE_AGENT);
    __syncthreads();
    if (tid == 0) { int acc = 0;
#pragma unroll 1
        for (int e = 0; e < 32; ++e) { const int c = PSTv[64 + e]; PSTv[e] = acc; acc += (c + 255) & ~255; } PSTv[32] = acc; }
    __syncthreads();
    int* slot_tok = (int*)(ws + WS_SLOTT); float* slot_w = (float*)(ws + WS_SLOTW); int* rbe = (int*)(ws + WS_RBE);
    if (blockIdx.x == 0) {
        const int nrb = PST[32] >> 8;
        if (tid == 0) rbe[128] = nrb;
        for (int rb = tid; rb < nrb; rb += NTHREADS) { int e = 0;
#pragma unroll 1
            for (int q = 0; q < 32; ++q) if (PSTv[q] <= rb * 256 && rb * 256 < PSTv[q + 1]) e = q;
            rbe[rb] = e; }
#pragma unroll 1
        for (int e = 0; e < 32; ++e) { const int s0 = PSTv[e] + PSTv[64 + e], s1 = PSTv[e + 1]; for (int s = s0 + tid; s < s1; s += NTHREADS) slot_tok[s] = -1; }
    }
    const int gw = blockIdx.x * NWAVES + wave, NGW = gridDim.x * NWAVES;
    const int* te = (const int*)(ws + WS_TOKE); const float* tw = (const float*)(ws + WS_TOKW); const int* tp = (const int*)(ws + WS_TOKP);
    const bf16_t* H2 = (const bf16_t*)(ws + WS_H); bf16_t* XS = (bf16_t*)(ws + WS_P);
    for (int pair = gw; pair < 16384; pair += NGW) { const int tok = pair >> 1; const int e = te[pair], pos = tp[pair]; const int slot = PST[e] + pos;
        const u32x4* src = (const u32x4*)(H2 + (size_t)tok * DM) + lane; u32x4* dst = (u32x4*)(XS + (size_t)slot * DM) + lane;
#pragma unroll
        for (int j = 0; j < 4; ++j) dst[64 * j] = src[64 * j];
        if (lane == 0) { slot_tok[slot] = pair; slot_w[slot] = tw[pair]; } }
}

__device__ __forceinline__ void p10_final(const KP& p, int tid, int lane, int wave) {
    unsigned char* ws = p.ws; const bf16_t* Y = (const bf16_t*)(ws + WS_P); const float* MODF = (const float*)(ws + WS_MODF);
    const int gw = blockIdx.x * NWAVES + wave, NGW = gridDim.x * NWAVES;
    for (int row = gw; row < NTOK; row += NGW) { const int b = row >> 11;
        f32x4* xr = (f32x4*)(p.out + (size_t)row * DM) + lane; const u32x2* y0 = (const u32x2*)(Y + (size_t)(2 * row) * DM) + lane; const u32x2* y1 = (const u32x2*)(Y + (size_t)(2 * row + 1) * DM) + lane;
        const f32x4* g2 = (const f32x4*)(MODF + (size_t)b * 12288 + 10240) + lane; const f32x4* nf = (const f32x4*)p.in(24) + lane;
        f32x4 v[8]; float s = 0.f;
#pragma unroll
        for (int j = 0; j < 8; ++j) { const f32x4 x = xr[64 * j]; const u32x2 a = y0[64 * j], c = y1[64 * j]; const f32x4 gg = g2[64 * j];
            f32x4 ys; ys.x = __uint_as_float(a.x << 16) + __uint_as_float(c.x << 16); ys.y = __uint_as_float(a.x & 0xffff0000u) + __uint_as_float(c.x & 0xffff0000u);
            ys.z = __uint_as_float(a.y << 16) + __uint_as_float(c.y << 16); ys.w = __uint_as_float(a.y & 0xffff0000u) + __uint_as_float(c.y & 0xffff0000u);
            v[j] = x + gg * ys; s += (v[j].x * v[j].x + v[j].y * v[j].y) + (v[j].z * v[j].z + v[j].w * v[j].w); }
        const float rstd = rsqrtf(wave_sum(s) * (1.0f / DM) + EPS);
#pragma unroll
        for (int j = 0; j < 8; ++j) xr[64 * j] = v[j] * rstd * nf[64 * j]; }
}

#define XB_TMO      128
#define XB_XCNT(j)  (256  + 64 * (j))
#define XB_XSUB(j)  (1280 + 64 * (j))
#define XB_XGEN(j)  (2304 + 64 * (j))
#define XB_TOP      3328
#define XB_TOPGEN   3392
#define XCD_BAR_WORDS 3456
#define XB_SPIN_CAP (1u << 18)

__device__ __forceinline__ unsigned xb_ld(unsigned* p)              { return __hip_atomic_load(p, __ATOMIC_RELAXED, __HIP_MEMORY_SCOPE_AGENT); }
__device__ __forceinline__ unsigned xb_add(unsigned* p, unsigned v) { return __hip_atomic_fetch_add(p, v, __ATOMIC_RELAXED, __HIP_MEMORY_SCOPE_AGENT); }
__device__ __forceinline__ unsigned xb_xcc_id() { return (unsigned)__builtin_amdgcn_s_getreg((3 << 11) | 20) & 0xFu; }
#define XB_SPIN(cond, bar) do { unsigned _sp = 0; while (cond) { __builtin_amdgcn_s_sleep(1); \
    if ((++_sp & 255u) == 0u) { if (xb_ld(&(bar)[XB_TMO])) break; if (_sp > XB_SPIN_CAP) { atomicAdd(&(bar)[XB_TMO], 1u); break; } } } } while (0)

struct XcdBarrier {
    unsigned* bar; unsigned x;
    volatile LAS unsigned* st;
};

__device__ __forceinline__ XcdBarrier xcd_barrier_post(unsigned* bar, volatile LAS unsigned* st) {
    XcdBarrier b; b.bar = bar; b.x = xb_xcc_id(); b.st = st;
    if (threadIdx.x == 0) (void)xb_add(&bar[XB_XCNT(b.x)], 1u);
    return b;
}
__device__ __forceinline__ void xcd_barrier_complete(unsigned* bar, unsigned x, unsigned& nloc, unsigned& nx) {
    const unsigned G = gridDim.x * gridDim.y * gridDim.z;
    unsigned sum, cnt, mine, sp = 0u;
    for (;;) {
        sum = 0u; cnt = 0u; mine = 0u;
#pragma unroll
        for (unsigned j = 0; j < 16; ++j) { const unsigned c = xb_ld(&bar[XB_XCNT(j)]); sum += c; cnt += (c > 0u) ? 1u : 0u; mine = (j == x) ? c : mine; }
        if (sum == G) break;
        __builtin_amdgcn_s_sleep(1);
        if ((++sp & 255u) == 0u) { if (xb_ld(&bar[XB_TMO])) break; if (sp > XB_SPIN_CAP) { atomicAdd(&bar[XB_TMO], 1u); break; } }
    }
    nloc = mine > 0u ? mine : 1u; nx = cnt > 0u ? cnt : 1u;
}

__device__ __forceinline__ void xcd_barrier(const XcdBarrier& b) {
    asm volatile("s_waitcnt vmcnt(0)" ::: "memory");
    __syncthreads();
    if (threadIdx.x == 0) {
        unsigned* bar = b.bar;
        __builtin_amdgcn_s_waitcnt(0);
        unsigned nloc = b.st[0], nx = b.st[1];
        if (nloc == 0u) { xcd_barrier_complete(bar, b.x, nloc, nx); b.st[0] = nloc; b.st[1] = nx; }
        const unsigned old = xb_add(&bar[XB_XSUB(b.x)], 1u);
        const unsigned gen = old / nloc;
        if (old + 1u == (gen + 1u) * nloc) {
            __builtin_amdgcn_fence(__ATOMIC_RELEASE, "agent");
            asm volatile("s_waitcnt vmcnt(0)" ::: "memory");
            const unsigned og = xb_add(&bar[XB_TOP], 1u);
            const unsigned tg = og / nx;
            if (og + 1u == (tg + 1u) * nx) xb_add(&bar[XB_TOPGEN], 1u);
            else XB_SPIN(xb_ld(&bar[XB_TOPGEN]) == tg, bar);
            __builtin_amdgcn_fence(__ATOMIC_ACQUIRE, "agent");
            xb_add(&bar[XB_XGEN(b.x)], 1u);
            asm volatile("s_waitcnt vmcnt(0)" ::: "memory");
        } else {
            XB_SPIN(xb_ld(&bar[XB_XGEN(b.x)]) == gen, bar);
            __builtin_amdgcn_fence(__ATOMIC_ACQUIRE, "agent");
            asm volatile("s_waitcnt vmcnt(0)" ::: "memory");
        }
    }
    __syncthreads();
}

__global__ void __launch_bounds__(NTHREADS, 2) fwd_megakernel(Params kargs) {
    extern __shared__ __attribute__((aligned(16))) unsigned char lds[];
    KP p; p.tab = (volatile LAS unsigned long long*)((LAS unsigned char*)lds + LDS_BYTES - 512); p.out = kargs.out; p.ws = kargs.ws;
    if (threadIdx.x == 0) {
#pragma unroll
        for (int i = 0; i < 25; ++i) p.tab[i] = (unsigned long long)kargs.in[i]; }
    __syncthreads();
    cg::grid_group grid = cg::this_grid();
    const int tid0 = threadIdx.x;
#define PHASE_IDS int tid = threadIdx.x; asm volatile("" : "+v"(tid)); const int lane = tid & 63, wave = __builtin_amdgcn_readfirstlane(tid >> 6); (void)lane; (void)wave;
    unsigned char* ws = p.ws; unsigned* ctl = (unsigned*)(ws + WS_CTL);
    volatile int* qslot = (volatile int*)(lds + LDS_BYTES - 64);
    LAS unsigned char* lds3 = (LAS unsigned char*)lds;
    if (p.ws == nullptr) grid.sync();
    volatile LAS unsigned* MISC = (volatile LAS unsigned*)(lds3 + LDS_BYTES - 128);
    if (tid0 < 16) MISC[tid0] = 0u;
    __syncthreads();
    XcdBarrier bar = xcd_barrier_post(ctl + CW_BAR, MISC + 8);
#define GSYNC() xcd_barrier(bar)

#ifndef REP_P0
#define REP_P0 1
#endif
    for (int rep = 0; rep < REP_P0; ++rep) {
    PHASE_IDS
#ifndef SKIP_P0
    p0_prologue(p, lds, tid, lane, wave);
#endif
    }
    GSYNC();
#ifndef REP_P1
#define REP_P1 1
#endif
    for (int rep = 0; rep < REP_P1; ++rep) {
    PHASE_IDS
#ifndef SKIP_P1
    p1_norm1(p, lds, tid, lane, wave);
#endif
    }
    GSYNC();
#ifndef REP_P2
#define REP_P2 1
#endif
    for (int rep = 0; rep < REP_P2; ++rep) {
    PHASE_IDS
#ifndef SKIP_G2
    { pg8::Gemm g{(const bf16_t*)(ws + WS_H), (const bf16_t*)(ws + WS_WIN), NTOK, PW, DM}; pg8::StaticOrder S; S.init(NTOK, PW, (int)gridDim.x, (int)blockIdx.x);
      pg8::EpiBf16<0> E{(bf16_t*)(ws + WS_P), PW, nullptr, 0, 0, 1.f};
      pg8::gemm_phase<pg8::EpiBf16<0>, pg8::StaticOrder, true, true>(lds3, g, S, E); }
#endif
    }
    GSYNC();
#ifndef REP_P3
#define REP_P3 1
#endif
    for (int rep = 0; rep < REP_P3; ++rep) {
    PHASE_IDS
    for (int it = fetch_item(ctl + CW_Q3 + 4 * rep, qslot, tid0); it < 512 + 512 + 256 + CONV_BITEMS; ) {
        const int nxt_ = fetch_issue(ctl + CW_Q3 + 4 * rep, tid0);
        PHASE_IDS
#ifndef REPU_WIN
#define REPU_WIN 1
#define REPU_GLA 1
#define REPU_CMP 1
#define REPU_SEL 1
#define REPU_GLC 1
#endif
        if (it < 512) { for (int q_ = 0; q_ < REPU_GLA; ++q_) { if (q_) __syncthreads(); gla_a_unit(p, lds, it, tid, lane, wave); } }
        else if (it < 1024) { const int u_ = it - 512; const int qblk = 31 - (u_ >> 4), bg = u_ & 15; for (int q_ = 0; q_ < REPU_WIN; ++q_) { if (q_) __syncthreads(); nsa_window_unit(p, lds, bg >> 2, bg & 3, qblk, tid, lane, wave); } }
        else if (it < 1024 + CONV_BITEMS) conv_block_item(p, lds, it - 1024, lane, wave);
        else { for (int q_ = 0; q_ < REPU_CMP; ++q_) { if (q_) __syncthreads(); nsa_compress_unit(p, lds, it - 1024 - CONV_BITEMS, tid, lane, wave); } }
        it = fetch_publish(nxt_, qslot, tid0); }
    }
    GSYNC();
#ifndef REP_P3B
#define REP_P3B 1
#endif
    for (int rep = 0; rep < REP_P3B; ++rep) {
    PHASE_IDS
#ifndef SKIP_SCAN
    gla_scan(p, tid);
#endif
    }
    GSYNC();
#ifndef REP_P4
#define REP_P4 1
#endif
    for (int rep = 0; rep < REP_P4; ++rep) {
    PHASE_IDS
    for (int it = fetch_item(ctl + CW_Q4 + 4 * rep, qslot, tid0); it < 1024; ) {
        const int nxt_ = fetch_issue(ctl + CW_Q4 + 4 * rep, tid0);
        PHASE_IDS
        if (it < 512) { const int qblk = 31 - (it >> 4), bg = it & 15; for (int q_ = 0; q_ < REPU_SEL; ++q_) { if (q_) __syncthreads(); nsa_cmp_sel_unit(p, lds, bg >> 2, bg & 3, qblk, tid, lane, wave); } }
        else { for (int q_ = 0; q_ < REPU_GLC; ++q_) { if (q_) __syncthreads(); gla_c_unit(p, lds, it - 512, tid, lane, wave); } }
        it = fetch_publish(nxt_, qslot, tid0); }
    }
    GSYNC();
#ifndef REP_P5
#define REP_P5 1
#endif
    for (int rep = 0; rep < REP_P5; ++rep) {
    PHASE_IDS
#ifndef SKIP_G5
    { pg8::Gemm g{(const bf16_t*)(ws + WS_H), (const bf16_t*)(ws + WS_WOUT), NTOK, DM, DM}; pg8::StaticOrder S; S.init(NTOK, DM, (int)gridDim.x, (int)blockIdx.x);
      pg8::EpiResid E{p.in(0), p.out, (const float*)(ws + WS_MODF) + 4096, (float*)(ws + WS_SSQP)};
      pg8::gemm_phase<pg8::EpiResid, pg8::StaticOrder, true, true>(lds3, g, S, E); }
#endif
    }
    GSYNC();
#ifndef SKIP_P6
    { PHASE_IDS p6_norm2_route(p, lds, tid, lane, wave); }
#endif
    GSYNC();
#ifndef REP_P7
#define REP_P7 1
#endif
    for (int rep = 0; rep < REP_P7; ++rep) {
    PHASE_IDS
#ifndef SKIP_P7
    p7_dispatch(p, lds, tid, lane, wave);
#endif
    }
    GSYNC();
    const int nrb = __hip_atomic_load((const int*)(ws + WS_RBE) + 128, __ATOMIC_RELAXED, __HIP_MEMORY_SCOPE_AGENT);
#ifndef REP_P8
#define REP_P8 1
#endif
    for (int rep = 0; rep < REP_P8; ++rep) {
    PHASE_IDS
#ifndef SKIP_G8
    { pg8::Gemm g{(const bf16_t*)(ws + WS_P), (const bf16_t*)(ws + WS_WGU), CAP, 32 * 1024, DM}; pg8::GroupedOrder S{(const int*)(ws + WS_RBE), nrb * 4, 4, (int)gridDim.x, (int)blockIdx.x};
      pg8::EpiSwiGLU E{(bf16_t*)(ws + WS_HMID)};
      pg8::gemm_phase<pg8::EpiSwiGLU, pg8::GroupedOrder, true, true>(lds3, g, S, E); }
#endif
    }
    GSYNC();
#ifndef REP_P9
#define REP_P9 1
#endif
    for (int rep = 0; rep < REP_P9; ++rep) {
    PHASE_IDS
#ifndef SKIP_G9
    { pg8::Gemm g{(const bf16_t*)(ws + WS_HMID), (const bf16_t*)(ws + WS_WD), CAP, 32 * 2048, 512}; pg8::GroupedOrder S{(const int*)(ws + WS_RBE), nrb * 8, 8, (int)gridDim.x, (int)blockIdx.x};
      pg8::EpiDown E{(bf16_t*)(ws + WS_P), (const int*)(ws + WS_SLOTT), (const float*)(ws + WS_SLOTW)};
      pg8::gemm_phase<pg8::EpiDown, pg8::GroupedOrder, true, true>(lds3, g, S, E); }
#endif
    }
    GSYNC();
#ifndef SKIP_P10
    { PHASE_IDS p10_final(p, tid, lane, wave); }
#endif
}

extern "C" void kernel_launch(void* const* d_in, const int* in_sizes, int n_in, void* d_out, int out_size, void* d_ws, size_t ws_size, hipStream_t stream) {
    static int grid_blocks = 0;
    if (!grid_blocks) {
        int dev = 0, cus = 0, per_cu = 0;
        (void)hipGetDevice(&dev);
        (void)hipDeviceGetAttribute(&cus, hipDeviceAttributeMultiprocessorCount, dev);
        (void)hipFuncSetAttribute((const void*)fwd_megakernel, hipFuncAttributeMaxDynamicSharedMemorySize, LDS_BYTES);
        (void)hipOccupancyMaxActiveBlocksPerMultiprocessor(&per_cu, (const void*)fwd_megakernel, NTHREADS, LDS_BYTES);
        if (per_cu < 1) fprintf(stderr, "kernel_launch: occupancy query reports %d blocks/CU\n", per_cu);
        grid_blocks = cus;
        if (ws_size < WS_END || n_in != 25) { fprintf(stderr, "kernel_launch: ws %zu < %zu or n_in %d != 25\n", ws_size, (size_t)WS_END, n_in); }
    }
    (void)hipMemsetAsync((char*)d_ws + WS_CTL, 0, CTL_ZERO_BYTES, stream);
    Params p{};
    for (int i = 0; i < 25; ++i) p.in[i] = (const float*)d_in[i];
    p.out = (float*)d_out; p.ws = (unsigned char*)d_ws;
    void* args[] = {&p};
    hipError_t e = hipLaunchCooperativeKernel((void*)fwd_megakernel, dim3(grid_blocks), dim3(NTHREADS), args, LDS_BYTES, stream);
    if (e != hipSuccess) fprintf(stderr, "cooperative launch failed: %s (grid %d)\n", hipGetErrorString(e), grid_blocks);
}
```
